# Optimizing an MI355X kernel written in HIP

```python
import math
import jax
import jax.numpy as jnp
from jax import lax
import numpy as np

D_MODEL = 1024
BATCH = 1
SEQ = 16384
DEPTH = 4

GRID_W = 64
CTX_LEN = 256
N_MIXERS = 4
HEAD_DIM = 64
ROPE_THETA = 10000.0
Q_BLOCK = 128
NORM_EPS = 1e-6
NEG_INF = -1e30

DA_HEADS = D_MODEL // (2 * HEAD_DIM)
DA_V_DIM = 2 * HEAD_DIM
SWA_HEADS = D_MODEL // HEAD_DIM
SWA_KV_HEADS = 4
SWA_WINDOW = 128
GA_HEADS = D_MODEL // HEAD_DIM
GA_KV_HEADS = 4
NA_HEADS = D_MODEL // HEAD_DIM
NA_ROWS = 8
NA_COLS = 16
N_GROUPS = 4
EXPERTS_PER_GROUP = 8
N_EXPERTS = N_GROUPS * EXPERTS_PER_GROUP
TOP_K = 2
D_EXPERT = D_MODEL // 2
MOE_BLOCK = 128

kernel_name = 'hybrid_diff_swa_axial_natten_hmoe_dit'


def _rmsnorm(x, g):
    xf = x.astype(jnp.float32)
    y = xf * lax.rsqrt(jnp.mean(xf * xf, axis=-1, keepdims=True) + NORM_EPS)
    return (y * g.astype(jnp.float32)).astype(x.dtype)


def _modulate(h, shift, scale):
    return h * (1 + scale) + shift


def _axial_rope_tables(n):
    t = jnp.arange(n, dtype=jnp.int32)
    pos = jnp.stack([t // GRID_W, t % GRID_W], axis=-1).astype(jnp.float32)
    quarter = HEAD_DIM // 4
    inv_freq = 1.0 / (ROPE_THETA ** (jnp.arange(quarter, dtype=jnp.float32) / quarter))
    ang = pos[:, :, None] * inv_freq
    return jnp.cos(ang), jnp.sin(ang)


def _rope(x, cos, sin):
    b, n, hh, d = x.shape
    xr = x.astype(jnp.float32).reshape(b, n, hh, 2, 2, d // 4)
    x1, x2 = xr[..., 0, :], xr[..., 1, :]
    cs, sn = cos[None, :, None], sin[None, :, None]
    out = jnp.stack([x1 * cs - x2 * sn, x2 * cs + x1 * sn], axis=-2)
    return out.reshape(b, n, hh, d).astype(x.dtype)


def _project(t, w, splits):
    b, n, _ = t.shape
    y = t @ w
    outs, off = [], 0
    for nh, dh in splits:
        outs.append(y[..., off:off + nh * dh].reshape(b, n, nh, dh))
        off += nh * dh
    return outs


def _sweep_queries(fn, q):
    b, s = q.shape[:2]
    nb = s // Q_BLOCK
    qb = jnp.swapaxes(q.reshape((b, nb, Q_BLOCK) + q.shape[2:]), 0, 1)
    ob = lax.map(fn, qb)
    return jnp.swapaxes(ob, 0, 1).reshape((b, s) + ob.shape[3:])


def _gqa_attend(q, k, v, sink=None, mask=None):
    b, nq, hq, d = q.shape
    hkv = k.shape[2]
    grp = hq // hkv
    qg = q.reshape(b, nq, hkv, grp, d)
    s = jnp.einsum('bqhgd,bkhd->bhgqk', qg, k).astype(jnp.float32) / math.sqrt(d)
    if mask is not None:
        s = jnp.where(mask, s, NEG_INF)
    if sink is None:
        p = jax.nn.softmax(s, axis=-1)
    else:
        sk = jnp.broadcast_to(sink.astype(jnp.float32).reshape(1, hkv, grp, 1, 1), s.shape[:-1] + (1,))
        p = jax.nn.softmax(jnp.concatenate([s, sk], axis=-1), axis=-1)[..., :-1]
    o = jnp.einsum('bhgqk,bkhd->bqhgd', p.astype(v.dtype), v)
    return o.reshape(b, nq, hq, v.shape[-1])


def _diff_attend(q, k, v, lam):
    s = jnp.einsum('bqhmd,bkhmd->bhmqk', q, k).astype(jnp.float32) / math.sqrt(q.shape[-1])
    p = jax.nn.softmax(s, axis=-1)
    a = p[:, :, 0] - lam * p[:, :, 1]
    return jnp.einsum('bhqk,bkhd->bqhd', a.astype(v.dtype), v)


def _diff_mixer(h, hc, w_qkv, w_o, lam_vecs, subln_g, lam_init, cos, sin, need_ctx):
    b, s, _ = h.shape
    lv = lam_vecs.astype(jnp.float32)
    lam = jnp.exp(jnp.sum(lv[0] * lv[1])) - jnp.exp(jnp.sum(lv[2] * lv[3])) + lam_init
    splits = [(2 * DA_HEADS, HEAD_DIM), (2 * DA_HEADS, HEAD_DIM), (DA_HEADS, DA_V_DIM)]
    q, k, v = _project(h, w_qkv, splits)
    qc, kc, vc = _project(hc, w_qkv, splits)
    q = _rope(q, cos, sin).reshape(b, s, DA_HEADS, 2, HEAD_DIM)
    k = _rope(k, cos, sin).reshape(b, s, DA_HEADS, 2, HEAD_DIM)
    kc = kc.reshape(b, -1, DA_HEADS, 2, HEAD_DIM)
    k_all = jnp.concatenate([kc, k], axis=1)
    v_all = jnp.concatenate([vc, v], axis=1)

    def out_proj(o):
        o = _rmsnorm(o, subln_g) * (1.0 - lam_init)
        return o.reshape(o.shape[0], o.shape[1], -1) @ w_o

    y = out_proj(_sweep_queries(lambda qb: _diff_attend(qb, k_all, v_all, lam), q))
    if not need_ctx:
        return y, None
    qc = qc.reshape(b, -1, DA_HEADS, 2, HEAD_DIM)
    return y, out_proj(_diff_attend(qc, kc, vc, lam))


def _swa_mixer(h, hc, w_qkv, w_o, sink, cos, sin, need_ctx):
    b, s, _ = h.shape
    n_ctx = hc.shape[1]
    nb = s // Q_BLOCK
    splits = [(SWA_HEADS, HEAD_DIM), (SWA_KV_HEADS, HEAD_DIM), (SWA_KV_HEADS, HEAD_DIM)]
    q, k, v = _project(h, w_qkv, splits)
    qc, kc, vc = _project(hc, w_qkv, splits)
    q, k = _rope(q, cos, sin), _rope(k, cos, sin)

    def band(t):
        tb = t.reshape((b, nb, Q_BLOCK) + t.shape[2:])
        tp = jnp.pad(tb, [(0, 0), (1, 1)] + [(0, 0)] * (tb.ndim - 2))
        tband = jnp.concatenate([tp[:, :-2], tp[:, 1:-1], tp[:, 2:]], axis=2)
        return jnp.swapaxes(tband, 0, 1)

    kb, vb = band(k), band(v)
    qb = jnp.swapaxes(q.reshape(b, nb, Q_BLOCK, SWA_HEADS, HEAD_DIM), 0, 1)
    qi = jnp.arange(Q_BLOCK)[:, None]
    kj = jnp.arange(3 * Q_BLOCK)[None, :]
    in_window = jnp.abs(kj - Q_BLOCK - qi) <= SWA_WINDOW
    ctx_ok = jnp.ones((Q_BLOCK, n_ctx), dtype=bool)

    def block(args):
        q_blk, k_blk, v_blk, bi = args
        kpos = bi * Q_BLOCK - Q_BLOCK + kj
        valid = in_window & (kpos >= 0) & (kpos < s)
        mask = jnp.concatenate([ctx_ok, valid], axis=-1)
        k_all = jnp.concatenate([kc, k_blk], axis=1)
        v_all = jnp.concatenate([vc, v_blk], axis=1)
        return _gqa_attend(q_blk, k_all, v_all, sink, mask)

    o = lax.map(block, (qb, kb, vb, jnp.arange(nb)))
    y = jnp.swapaxes(o, 0, 1).reshape(b, s, -1) @ w_o
    if not need_ctx:
        return y, None
    return y, _gqa_attend(qc, kc, vc, sink).reshape(b, n_ctx, -1) @ w_o


def _axial_gqa_mixer(h, hc, w_qkv, w_o, qk_g, cos, sin, need_ctx):
    b, s, _ = h.shape
    n_ctx = hc.shape[1]
    splits = [(GA_HEADS, HEAD_DIM), (GA_KV_HEADS, HEAD_DIM), (GA_KV_HEADS, HEAD_DIM)]
    q, k, v = _project(h, w_qkv, splits)
    qc, kc, vc = _project(hc, w_qkv, splits)
    q, k = _rmsnorm(q, qk_g[0]), _rmsnorm(k, qk_g[1])
    qc, kc = _rmsnorm(qc, qk_g[0]), _rmsnorm(kc, qk_g[1])
    q, k = _rope(q, cos, sin), _rope(k, cos, sin)
    k_all = jnp.concatenate([kc, k], axis=1)
    v_all = jnp.concatenate([vc, v], axis=1)
    o = _sweep_queries(lambda qb: _gqa_attend(qb, k_all, v_all), q)
    y = o.reshape(b, s, -1) @ w_o
    if not need_ctx:
        return y, None
    return y, _gqa_attend(qc, kc, vc).reshape(b, n_ctx, -1) @ w_o


def _na_mixer(h, hc, w_qkv, w_o, rpb, need_ctx):
    b, s, _ = h.shape
    n_ctx = hc.shape[1]
    rows = s // GRID_W
    kh = min(NA_ROWS, rows)
    splits = [(NA_HEADS, HEAD_DIM)] * 3
    q, k, v = _project(h, w_qkv, splits)
    qc, kc, vc = _project(hc, w_qkv, splits)
    q_g = q.reshape(b, rows, GRID_W, NA_HEADS, HEAD_DIM)
    k_g = k.reshape(b, rows, GRID_W, NA_HEADS, HEAD_DIM)
    v_g = v.reshape(b, rows, GRID_W, NA_HEADS, HEAD_DIM)
    cols = np.arange(GRID_W)
    col_idx = np.clip(cols - NA_COLS // 2, 0, GRID_W - NA_COLS)[:, None] + np.arange(NA_COLS)[None, :]
    dc_idx = col_idx - cols[:, None] + (NA_COLS - 1)
    bias_c = rpb.astype(jnp.float32)[:, :, dc_idx]
    scale = 1.0 / math.sqrt(HEAD_DIM)
    n_nb = kh * NA_COLS

    def row_step(args):
        q_r, r = args
        r0 = jnp.clip(r - kh // 2, 0, rows - kh)
        k_r = lax.dynamic_slice_in_dim(k_g, r0, kh, axis=1)[:, :, col_idx]
        v_r = lax.dynamic_slice_in_dim(v_g, r0, kh, axis=1)[:, :, col_idx]
        dr_idx = r0 + jnp.arange(kh) - r + (NA_ROWS - 1)
        bias = jnp.take(bias_c, dr_idx, axis=1).transpose(0, 2, 1, 3)
        s_nb = jnp.einsum('bchd,bkcwhd->bhckw', q_r, k_r).astype(jnp.float32) * scale + bias[None]
        s_cx = jnp.einsum('bchd,bnhd->bhcn', q_r, kc).astype(jnp.float32) * scale
        logits = jnp.concatenate([s_nb.reshape(b, NA_HEADS, GRID_W, n_nb), s_cx], axis=-1)
        p = jax.nn.softmax(logits, axis=-1).astype(v.dtype)
        p_nb = p[..., :n_nb].reshape(b, NA_HEADS, GRID_W, kh, NA_COLS)
        return (jnp.einsum('bhckw,bkcwhd->bchd', p_nb, v_r)
                + jnp.einsum('bhcn,bnhd->bchd', p[..., n_nb:], vc))

    o = lax.map(row_step, (jnp.swapaxes(q_g, 0, 1), jnp.arange(rows)))
    y = jnp.swapaxes(o, 0, 1).reshape(b, s, -1) @ w_o
    if not need_ctx:
        return y, None
    return y, _gqa_attend(qc, kc, vc).reshape(b, n_ctx, -1) @ w_o


def _hier_moe(t, wr_g, br_g, wr_e, br_e, w_gate, w_up, w_down):
    n_tok, d = t.shape
    lg = (t @ wr_g).astype(jnp.float32) + br_g.astype(jnp.float32)
    pg = jax.nn.softmax(lg, axis=-1)
    g = jnp.argmax(lg, axis=-1)
    gate_g = jnp.take_along_axis(pg, g[:, None], axis=1)
    le = ((t @ wr_e).astype(jnp.float32) + br_e.astype(jnp.float32)).reshape(n_tok, N_GROUPS, EXPERTS_PER_GROUP)
    le_g = jnp.take_along_axis(le, g[:, None, None], axis=1)[:, 0]
    top_v, top_i = lax.top_k(le_g, TOP_K)
    weights = (gate_g * jax.nn.softmax(top_v, axis=-1)).reshape(-1)
    expert = (g[:, None] * EXPERTS_PER_GROUP + top_i).reshape(-1)
    tok = jnp.repeat(jnp.arange(n_tok, dtype=jnp.int32), TOP_K)
    n_assign = n_tok * TOP_K
    order = jnp.argsort(expert, stable=True)
    e_sorted = expert[order]
    counts = jax.ops.segment_sum(jnp.ones_like(expert), expert, num_segments=N_EXPERTS)
    padded = (counts + MOE_BLOCK - 1) // MOE_BLOCK * MOE_BLOCK
    p_end = jnp.cumsum(padded)
    p_start = p_end - padded
    start = jnp.cumsum(counts) - counts
    dest = p_start[e_sorted] + jnp.arange(n_assign) - start[e_sorted]
    cap = -(-n_assign // MOE_BLOCK) * MOE_BLOCK + N_EXPERTS * MOE_BLOCK
    n_blk = cap // MOE_BLOCK
    buf_tok = jnp.full((cap,), n_tok, jnp.int32).at[dest].set(tok[order])
    buf_w = jnp.zeros((cap,), jnp.float32).at[dest].set(weights[order])
    blk_e = jnp.clip(jnp.searchsorted(p_end, jnp.arange(n_blk) * MOE_BLOCK, side='right'), 0, N_EXPERTS - 1)
    t_pad = jnp.concatenate([t, jnp.zeros((1, d), t.dtype)], axis=0)
    xb = t_pad[buf_tok].reshape(n_blk, MOE_BLOCK, d)

    def expert_block(args):
        x_blk, e = args
        hidden = jax.nn.silu(x_blk @ w_gate[e]) * (x_blk @ w_up[e])
        return hidden @ w_down[e]

    yb = lax.map(expert_block, (xb, blk_e)).reshape(cap, d)
    out = jnp.zeros((n_tok + 1, d), t.dtype).at[buf_tok].add(yb * buf_w[:, None].astype(yb.dtype))
    return out[:n_tok]


def _n_layers_of(m):
    return len(range(m, DEPTH, N_MIXERS))


def setup_inputs(seed: int = 0) -> dict:
    key = jax.random.key(seed)
    keys = iter(jax.random.split(key, 64))

    def nrm(shape, std):
        return std * jax.random.normal(next(keys), shape, jnp.float32)

    D = D_MODEL
    n_a, n_b, n_c, n_d = (_n_layers_of(m) for m in range(N_MIXERS))
    a_cols = 4 * DA_HEADS * HEAD_DIM + DA_HEADS * DA_V_DIM
    b_cols = (SWA_HEADS + 2 * SWA_KV_HEADS) * HEAD_DIM
    c_cols = (GA_HEADS + 2 * GA_KV_HEADS) * HEAD_DIM
    d_cols = 3 * NA_HEADS * HEAD_DIM
    return {
        'x': nrm((BATCH, SEQ, D), 1.0),
        'c': nrm((BATCH, D), 1.0),
        'ctx': nrm((BATCH, CTX_LEN, D), 1.0),
        'c_ctx': nrm((D,), 1.0),
        'mod_w': nrm((DEPTH, D, 6 * D), 0.5 / math.sqrt(D)),
        'mod_b': nrm((DEPTH, 6 * D), 0.02),
        'norm1_g': 1.0 + nrm((DEPTH, D), 0.02),
        'norm2_g': 1.0 + nrm((DEPTH, D), 0.02),
        'a_w_qkv': nrm((n_a, D, a_cols), D ** -0.5),
        'a_w_o': nrm((n_a, DA_HEADS * DA_V_DIM, D), (DA_HEADS * DA_V_DIM) ** -0.5),
        'a_lam': nrm((n_a, 4, HEAD_DIM), 0.1),
        'a_subln_g': 1.0 + nrm((n_a, DA_V_DIM), 0.02),
        'b_w_qkv': nrm((n_b, D, b_cols), D ** -0.5),
        'b_w_o': nrm((n_b, SWA_HEADS * HEAD_DIM, D), (SWA_HEADS * HEAD_DIM) ** -0.5),
        'b_sink': nrm((n_b, SWA_HEADS), 0.5),
        'c_w_qkv': nrm((n_c, D, c_cols), D ** -0.5),
        'c_w_o': nrm((n_c, GA_HEADS * HEAD_DIM, D), (GA_HEADS * HEAD_DIM) ** -0.5),
        'c_qk_norm_g': 1.0 + nrm((n_c, 2, HEAD_DIM), 0.02),
        'd_w_qkv': nrm((n_d, D, d_cols), D ** -0.5),
        'd_w_o': nrm((n_d, NA_HEADS * HEAD_DIM, D), (NA_HEADS * HEAD_DIM) ** -0.5),
        'd_rpb': nrm((n_d, NA_HEADS, 2 * NA_ROWS - 1, 2 * NA_COLS - 1), 0.1),
        'moe_router_g': nrm((DEPTH, D, N_GROUPS), D ** -0.5),
        'moe_router_g_b': nrm((DEPTH, N_GROUPS), 0.01),
        'moe_router_e': nrm((DEPTH, D, N_EXPERTS), D ** -0.5),
        'moe_router_e_b': nrm((DEPTH, N_EXPERTS), 0.01),
        'moe_w_gate': nrm((DEPTH, N_EXPERTS, D, D_EXPERT), D ** -0.5),
        'moe_w_up': nrm((DEPTH, N_EXPERTS, D, D_EXPERT), D ** -0.5),
        'moe_w_down': nrm((DEPTH, N_EXPERTS, D_EXPERT, D), D_EXPERT ** -0.5),
        'final_g': 1.0 + nrm((D,), 0.02),
    }


def reference(x, c, ctx, c_ctx, mod_w, mod_b, norm1_g, norm2_g,
              a_w_qkv, a_w_o, a_lam, a_subln_g,
              b_w_qkv, b_w_o, b_sink,
              c_w_qkv, c_w_o, c_qk_norm_g,
              d_w_qkv, d_w_o, d_rpb,
              moe_router_g, moe_router_g_b, moe_router_e, moe_router_e_b,
              moe_w_gate, moe_w_up, moe_w_down, final_g):
    b, s, d = x.shape
    n_ctx = ctx.shape[1]
    cos, sin = _axial_rope_tables(s)
    xc = ctx
    for i in range(DEPTH):
        m, j = i % N_MIXERS, i // N_MIXERS
        need_ctx = i < DEPTH - 1
        mod = jax.nn.silu(c) @ mod_w[i] + mod_b[i]
        sh1, sc1, g1, sh2, sc2, g2 = jnp.split(mod[:, None, :], 6, axis=-1)
        mod_c = jax.nn.silu(c_ctx) @ mod_w[i] + mod_b[i]
        shc1, scc1, gc1, shc2, scc2, gc2 = jnp.split(mod_c, 6)
        h = _modulate(_rmsnorm(x, norm1_g[i]), sh1, sc1)
        hc = _modulate(_rmsnorm(xc, norm1_g[i]), shc1, scc1)
        if m == 0:
            lam_init = 0.8 - 0.6 * math.exp(-0.3 * i)
            y, yc = _diff_mixer(h, hc, a_w_qkv[j], a_w_o[j], a_lam[j], a_subln_g[j], lam_init, cos, sin, need_ctx)
        elif m == 1:
            y, yc = _swa_mixer(h, hc, b_w_qkv[j], b_w_o[j], b_sink[j], cos, sin, need_ctx)
        elif m == 2:
            y, yc = _axial_gqa_mixer(h, hc, c_w_qkv[j], c_w_o[j], c_qk_norm_g[j], cos, sin, need_ctx)
        else:
            y, yc = _na_mixer(h, hc, d_w_qkv[j], d_w_o[j], d_rpb[j], need_ctx)
        x = x + g1 * y
        h2 = _modulate(_rmsnorm(x, norm2_g[i]), sh2, sc2).reshape(b * s, d)
        if need_ctx:
            xc = xc + gc1 * yc
            h2c = _modulate(_rmsnorm(xc, norm2_g[i]), shc2, scc2).reshape(b * n_ctx, d)
            tokens = jnp.concatenate([h2, h2c], axis=0)
        else:
            tokens = h2
        f = _hier_moe(tokens, moe_router_g[i], moe_router_g_b[i], moe_router_e[i], moe_router_e_b[i],
                      moe_w_gate[i], moe_w_up[i], moe_w_down[i])
        x = x + g2 * f[:b * s].reshape(b, s, d)
        if need_ctx:
            xc = xc + gc2 * f[b * s:].reshape(b, n_ctx, d)
    return _rmsnorm(x, final_g)
```

```cpp
#include <hip/hip_runtime.h>
#include <cstdio>
#include <cstdint>

typedef unsigned short bf16;
typedef float f32x4 __attribute__((ext_vector_type(4)));
typedef float f32x2 __attribute__((ext_vector_type(2)));
typedef unsigned u32x4 __attribute__((ext_vector_type(4)));
typedef unsigned u32x2 __attribute__((ext_vector_type(2)));

constexpr int D = 1024, SEQ = 16384, CTX = 256, T = SEQ + CTX, DEPTH = 4, HD = 64;
constexpr int NEXP = 32, DEXP = 512;
constexpr float EPS = 1e-6f;
constexpr int XB_ROWS = 41472;

constexpr size_t MiB = 1u << 20;
constexpr size_t WS_CTL = 0, CTL_ZERO_BYTES = 256 * 1024;
constexpr size_t WS_MODV = 1 * MiB;
constexpr size_t WS_ROPE = 1 * MiB + 512 * 1024;
constexpr size_t WS_RTE = 2 * MiB;
constexpr size_t WS_RTP = 2 * MiB + 256 * 1024;
constexpr size_t WS_RTW = 2 * MiB + 512 * 1024;
constexpr size_t WS_LAM = 3 * MiB;
constexpr size_t WS_WRT = 3 * MiB + 65536;
constexpr size_t WS_WQKV = 4 * MiB, WS_WO = 22 * MiB, WS_WG = 32 * MiB, WS_WD = 288 * MiB;
constexpr size_t WS_X = 416 * MiB, WS_H = 481 * MiB, WS_QKV = 514 * MiB, WS_XB = WS_QKV, WS_O = 612 * MiB, WS_HID = 645 * MiB, WS_YB = 686 * MiB, WS_OSCR = 767 * MiB, WS_END = 832 * MiB;
constexpr size_t WS_LIST = WS_OSCR;
constexpr int LCAP = T;
constexpr size_t WS_NSCR = 832 * MiB;
constexpr int CW_CNT = 1024;
constexpr int CW_QKMAX = 2048;
constexpr int CW_BAR = 8192;
constexpr int RING_BYTES = 131072, MISC_OFF = 147456, LDS_BYTES = MISC_OFF + 4096;

struct P { const float* in[29]; float* out; unsigned char* ws; };
enum { I_X = 0, I_C, I_CTX, I_CCTX, I_MODW, I_MODB, I_N1G, I_N2G, I_AQKV, I_AWO, I_ALAM, I_ASUB, I_BQKV, I_BWO, I_BSINK, I_CQKV, I_CWO, I_CQKN, I_DQKV, I_DWO, I_DRPB,
       I_RG, I_RGB, I_RE, I_REB, I_WGATE, I_WUP, I_WDOWN, I_FING };

__device__ __forceinline__ unsigned f2bf(float f) { unsigned u = __builtin_bit_cast(unsigned, f); return (u + 0x7fffu + ((u >> 16) & 1u)) >> 16; }
__device__ __forceinline__ unsigned pk2(float lo, float hi) { typedef float f2_t_ __attribute__((ext_vector_type(2))); typedef __bf16 b2_t_ __attribute__((ext_vector_type(2)));
    f2_t_ v = {lo, hi}; b2_t_ b = __builtin_convertvector(v, b2_t_); return __builtin_bit_cast(unsigned, b); }
__device__ __forceinline__ float bf2f(unsigned short b) { return __builtin_bit_cast(float, (unsigned)b << 16); }
__device__ __forceinline__ float bflo(unsigned w) { return __builtin_bit_cast(float, w << 16); }
__device__ __forceinline__ float bfhi(unsigned w) { return __builtin_bit_cast(float, w & 0xffff0000u); }
__device__ __forceinline__ float wave_sum(float v) {
#pragma unroll
    for (int o = 1; o < 64; o <<= 1) v += __shfl_xor(v, o);
    return v;
}
__device__ __forceinline__ float wave_max(float v) {
#pragma unroll
    for (int o = 1; o < 64; o <<= 1) v = fmaxf(v, __shfl_xor(v, o));
    return v;
}
__device__ __forceinline__ float silu(float x) { return x / (1.f + expf(-x)); }

__device__ __forceinline__ void ph_modvec(const P& p, unsigned char* lds) {
    float (*s_c)[1024] = (float (*)[1024])lds;
    float (*s_red)[2][128] = (float (*)[2][128])(lds + 8192);
    const int tid = threadIdx.x, wave = tid >> 6, lane = tid & 63;
    float* modv = (float*)(p.ws + WS_MODV);
    for (int i = tid; i < 1024; i += 512) { s_c[0][i] = silu(p.in[I_C][i]); s_c[1][i] = silu(p.in[I_CCTX][i]); }
    __syncthreads();
    for (int item = blockIdx.x; item < 192; item += gridDim.x) {
        const int l = item / 48, ch = item % 48;
        const float* W = p.in[I_MODW] + (size_t)l * 1024 * 6144 + ch * 128 + lane * 2;
        float a0 = 0.f, a1 = 0.f, b0 = 0.f, b1 = 0.f;
#pragma unroll 8
        for (int k = wave * 128; k < wave * 128 + 128; ++k) {
            const f32x2 w = *(const f32x2*)(W + (size_t)k * 6144);
            const float sl = s_c[0][k], sc = s_c[1][k];
            a0 += sl * w.x; a1 += sl * w.y; b0 += sc * w.x; b1 += sc * w.y;
        }
        s_red[wave][0][lane * 2] = a0; s_red[wave][0][lane * 2 + 1] = a1; s_red[wave][1][lane * 2] = b0; s_red[wave][1][lane * 2 + 1] = b1;
        __syncthreads();
        if (tid < 256) { const int which = tid >> 7, c = tid & 127; float s = 0.f;
#pragma unroll
            for (int w = 0; w < 8; ++w) s += s_red[w][which][c];
            modv[(size_t)(l * 2 + which) * 6144 + ch * 128 + c] = s + p.in[I_MODB][l * 6144 + ch * 128 + c]; }
        __syncthreads();
    }
    if (blockIdx.x == gridDim.x - 1) {
        float* rope = (float*)(p.ws + WS_ROPE);
        for (int i = tid; i < 256 * 16; i += 512) { const int pos = i >> 4, c = i & 15;
            const float inv = 1.0f / powf(10000.f, (float)c / 16.f); const float ang = (float)pos * inv;
            rope[i * 2] = cosf(ang); rope[i * 2 + 1] = sinf(ang); }
        if (wave == 0) { const float* lv = p.in[I_ALAM];
            const float s1 = wave_sum(lv[lane] * lv[64 + lane]), s2 = wave_sum(lv[128 + lane] * lv[192 + lane]);
            if (lane == 0) ((float*)(p.ws + WS_LAM))[0] = expf(s1) - expf(s2) + 0.2f; }
    }
}

struct RowV { f32x4 v[4]; };
__device__ __forceinline__ RowV ldrow(const float* p, int lane) { RowV r; const f32x4* q = (const f32x4*)p + lane;
#pragma unroll
    for (int j = 0; j < 4; ++j) r.v[j] = q[64 * j]; return r; }
__device__ __forceinline__ void strow(float* p, int lane, const RowV& r) { f32x4* q = (f32x4*)p + lane;
#pragma unroll
    for (int j = 0; j < 4; ++j) q[64 * j] = r.v[j]; }
__device__ __forceinline__ RowV ldrow_bf(const bf16* p, int lane) { RowV r; const u32x2* q = (const u32x2*)p + lane;
#pragma unroll
    for (int j = 0; j < 4; ++j) { const u32x2 w = q[64 * j]; r.v[j] = (f32x4){bflo(w.x), bfhi(w.x), bflo(w.y), bfhi(w.y)}; } return r; }
__device__ __forceinline__ void strow_bf(bf16* p, int lane, const RowV& r) { u32x2* q = (u32x2*)p + lane;
#pragma unroll
    for (int j = 0; j < 4; ++j) { u32x2 w; w.x = pk2(r.v[j].x, r.v[j].y); w.y = pk2(r.v[j].z, r.v[j].w); q[64 * j] = w; } }
__device__ __forceinline__ float row_ss(const RowV& r) { float s = 0.f;
#pragma unroll
    for (int j = 0; j < 4; ++j) s += (r.v[j].x * r.v[j].x + r.v[j].y * r.v[j].y) + (r.v[j].z * r.v[j].z + r.v[j].w * r.v[j].w);
    return wave_sum(s); }

__device__ __forceinline__ void moe_prefix(const int* gcnt, int* ps) {
    if (threadIdx.x < 64) { const int lane = threadIdx.x; int v = lane < 32 ? (gcnt[lane] + 255) / 256 * 256 : 0;
#pragma unroll
        for (int d = 1; d < 32; d <<= 1) { const int t = __shfl_up(v, d); if (lane >= d) v += t; }
        if (lane < 32) ps[lane + 1] = v;
        if (lane == 0) ps[0] = 0; }
    __syncthreads();
}
template <int L> __device__ __forceinline__ void norm1_rows(const P& p, const int* ps, int gw, int ngw, int lane, bool ctxpart) {
    float* X = (float*)(p.ws + WS_X); bf16* H = (bf16*)(p.ws + WS_H); const bf16* YB = (const bf16*)(p.ws + WS_YB);
    const float* modv = (const float*)(p.ws + WS_MODV);
    const int* rtp = (const int*)(p.ws + WS_RTP); const int* rte = (const int*)(p.ws + WS_RTE); const float* rtw = (const float*)(p.ws + WS_RTW);
    const int which = ctxpart ? 1 : 0;
    RowV g2{}, sh{}, sc{}, ng{};
    if (L > 0) g2 = ldrow(modv + (size_t)((L - 1) * 2 + which) * 6144 + 5120, lane);
    if (L < 4) { sh = ldrow(modv + (size_t)(L * 2 + which) * 6144, lane); sc = ldrow(modv + (size_t)(L * 2 + which) * 6144 + 1024, lane); ng = ldrow(p.in[I_N1G] + L * 1024, lane); }
    else ng = ldrow(p.in[I_FING], lane);
    const int m0 = ctxpart ? 0 : CTX, m1 = ctxpart ? CTX : T;
    for (int m = m0 + gw; m < m1; m += ngw) {
        RowV x;
        if (L == 0) x = ctxpart ? ldrow(p.in[I_CTX] + (size_t)m * D, lane) : ldrow(p.in[I_X] + (size_t)(m - CTX) * D, lane);
        else {
            x = ldrow(X + (size_t)m * D, lane);
            const int p0 = ps[rte[m * 2]] + rtp[m * 2], p1 = ps[rte[m * 2 + 1]] + rtp[m * 2 + 1]; const float w0 = rtw[m * 2], w1 = rtw[m * 2 + 1];
            const RowV y0 = ldrow_bf(YB + (size_t)p0 * D, lane), y1 = ldrow_bf(YB + (size_t)p1 * D, lane);
#pragma unroll
            for (int j = 0; j < 4; ++j) x.v[j] += g2.v[j] * (y0.v[j] * w0 + y1.v[j] * w1);
        }
        if (L < 4) strow(X + (size_t)m * D, lane, x);
        const float r = 1.0f / sqrtf(row_ss(x) * (1.f / D) + EPS);
        RowV h;
        if (L < 4) {
#pragma unroll
            for (int j = 0; j < 4; ++j) h.v[j] = (x.v[j] * r) * ng.v[j] * (1.f + sc.v[j]) + sh.v[j];
            strow_bf(H + (size_t)m * D, lane, h);
        } else {
#pragma unroll
            for (int j = 0; j < 4; ++j) h.v[j] = (x.v[j] * r) * ng.v[j];
            strow(p.out + (size_t)(m - CTX) * D, lane, h);
        }
    }
}
template <int L> __device__ __forceinline__ void ph_norm1(const P& p, unsigned char* lds) {
    const int lane = threadIdx.x & 63, gw = blockIdx.x * 8 + (threadIdx.x >> 6), ngw = gridDim.x * 8;
    int* ps = (int*)(lds + MISC_OFF + 64);
    if (L > 0) { __syncthreads(); moe_prefix((const int*)(p.ws + WS_CTL) + CW_CNT + (L - 1) * 32, ps); }
    if (L < 4) { const int cw = ((int)blockIdx.x < CTX && (int)(threadIdx.x >> 6) == ((int)blockIdx.x & 7)) ? (int)blockIdx.x : CTX;
        if (cw < CTX) norm1_rows<L>(p, ps, cw, CTX, lane, true); }
    norm1_rows<L>(p, ps, gw, ngw, lane, false);
}

__device__ __forceinline__ float dpp_row_sum(float v) {
    v += __int_as_float(__builtin_amdgcn_update_dpp(0, __float_as_int(v), 0xB1, 0xf, 0xf, true));
    v += __int_as_float(__builtin_amdgcn_update_dpp(0, __float_as_int(v), 0x4E, 0xf, 0xf, true));
    v += __int_as_float(__builtin_amdgcn_update_dpp(0, __float_as_int(v), 0x141, 0xf, 0xf, true));
    v += __int_as_float(__builtin_amdgcn_update_dpp(0, __float_as_int(v), 0x140, 0xf, 0xf, true));
    return v;
}
__device__ __forceinline__ float reduce4(float a, float b, float c, float d, int lane) {
    a = dpp_row_sum(a); b = dpp_row_sum(b); c = dpp_row_sum(c); d = dpp_row_sum(d);
    const bool odd = (lane >> 4) & 1;
    const float ab = (odd ? b : a) + __shfl_xor(odd ? a : b, 16);
    const float cd = (odd ? d : c) + __shfl_xor(odd ? c : d, 16);
    auto rr = __builtin_amdgcn_permlane32_swap(__float_as_uint(ab), __float_as_uint(cd), false, false);
    return __uint_as_float(rr[0]) + __uint_as_float(rr[1]);
}
__device__ __forceinline__ void route_row(const float* lg_, int m, int* cnt_l, int* rte, float* rtw, bool active_, int& ea_o, int& eb_o, int& ra_o, int& rb_o) {
    float lg[4];
#pragma unroll
    for (int n = 0; n < 4; ++n) lg[n] = lg_[n];
    int g = 0; float gm = lg[0];
#pragma unroll
    for (int n = 1; n < 4; ++n) if (lg[n] > gm) { gm = lg[n]; g = n; }
    float gs = 0.f;
#pragma unroll
    for (int n = 0; n < 4; ++n) gs += expf(lg[n] - gm);
    const float gate_g = 1.0f / gs;
    float le[8];
#pragma unroll
    for (int i = 0; i < 8; ++i) le[i] = lg_[4 + g * 8 + i];
    int i0 = 0; float v0 = le[0];
#pragma unroll
    for (int i = 1; i < 8; ++i) if (le[i] > v0) { v0 = le[i]; i0 = i; }
    int i1 = -1; float v1 = -INFINITY;
#pragma unroll
    for (int i = 0; i < 8; ++i) if (i != i0 && le[i] > v1) { v1 = le[i]; i1 = i; }
    const float e1 = expf(v1 - v0); const float w0 = gate_g / (1.f + e1), w1 = gate_g * e1 / (1.f + e1);
    ea_o = g * 8 + i0; eb_o = g * 8 + i1; ra_o = 0; rb_o = 0;
    if (active_) { ra_o = atomicAdd(&cnt_l[ea_o], 1); rb_o = atomicAdd(&cnt_l[eb_o], 1);
        rte[m * 2] = ea_o; rte[m * 2 + 1] = eb_o; rtw[m * 2] = w0; rtw[m * 2 + 1] = w1; }
}
typedef short n2_bf16x8 __attribute__((ext_vector_type(8)));
__device__ __forceinline__ void split_hl(float x, unsigned& h, unsigned& l) { h = f2bf(x); l = f2bf(x - __builtin_bit_cast(float, h << 16)); }
__device__ __forceinline__ void split_hl2(float x0, float x1, unsigned& hw, unsigned& lw) { hw = pk2(x0, x1);
    lw = pk2(x0 - __builtin_bit_cast(float, hw << 16), x1 - __builtin_bit_cast(float, hw & 0xffff0000u)); }
template <int L> __device__ __forceinline__ int n2_row(int b, int slot) {
    if (b < 0) return (L < 3 && slot == 0 && (int)blockIdx.x < CTX) ? (int)blockIdx.x : -1;
    const int m = CTX + (int)blockIdx.x + (int)gridDim.x * (16 * b + slot); return m < T ? m : -1;
}
template <int L> __device__ __forceinline__ void ph_norm2(const P& p, unsigned char* lds) {
    constexpr int A_HI = 0, A_LO = 32768, PART = 65536, LGS = PART + 8 * 16 * 48 * 4;
    constexpr int CI_HI = 94208, CI_LO = 96256, CPART = 98304, LGA = 102400;
    const bool has_c = L < 3 && (int)blockIdx.x < CTX;
    int* cnt_l = (int*)(lds + MISC_OFF + 256); int* base_l = cnt_l + 32;
    const int tid = threadIdx.x, lane = tid & 63, wave = __builtin_amdgcn_readfirstlane(tid >> 6);
    float* X = (float*)(p.ws + WS_X); bf16* H = (bf16*)(p.ws + WS_H);
    const float* modv = (const float*)(p.ws + WS_MODV);
    int* rte = (int*)(p.ws + WS_RTE); int* rtp = (int*)(p.ws + WS_RTP); float* rtw = (float*)(p.ws + WS_RTW);
    int* gcnt = (int*)(p.ws + WS_CTL) + CW_CNT + L * 32; int* list = (int*)(p.ws + WS_LIST);
    float* bias_l = (float*)(lds + MISC_OFF + 1024);
    if (tid < 36) bias_l[tid] = tid < 4 ? p.in[I_RGB][L * 4 + tid] : p.in[I_REB][L * 32 + tid - 4];
    if (tid < 32) cnt_l[tid] = 0;
    n2_bf16x8 Bh[3][4], Bl[3][4];
    { const float* wrt = (const float*)(p.ws + WS_WRT) + (size_t)L * 36 * 1024;
#pragma unroll
      for (int nt = 0; nt < 3; ++nt)
#pragma unroll
          for (int ks = 0; ks < 4; ++ks) { const int n = 16 * nt + (lane & 15), k0 = 128 * wave + 32 * ks + 8 * (lane >> 4);
              f32x4 a = {0.f, 0.f, 0.f, 0.f}, b = {0.f, 0.f, 0.f, 0.f};
              if (n < 36) { a = *(const f32x4*)(wrt + n * 1024 + k0); b = *(const f32x4*)(wrt + n * 1024 + k0 + 4); }
              unsigned h_[4], l_[4];
              split_hl2(a.x, a.y, h_[0], l_[0]); split_hl2(a.z, a.w, h_[1], l_[1]); split_hl2(b.x, b.y, h_[2], l_[2]); split_hl2(b.z, b.w, h_[3], l_[3]);
              u32x4 hw = {h_[0], h_[1], h_[2], h_[3]}, lw = {l_[0], l_[1], l_[2], l_[3]};
              Bh[nt][ks] = *reinterpret_cast<n2_bf16x8*>(&hw); Bl[nt][ks] = *reinterpret_cast<n2_bf16x8*>(&lw); } }
    __syncthreads();
    const int nbatch = (SEQ / (int)gridDim.x + 15) / 16 + 1;
    const RowV ng = ldrow(p.in[I_N2G] + L * 1024, lane), sh = ldrow(modv + (size_t)(L * 2) * 6144 + 3072, lane), sc = ldrow(modv + (size_t)(L * 2) * 6144 + 4096, lane);
    for (int b = 0; b < nbatch; ++b) {
        if (n2_row<L>(b, 0) < 0) break;
        const bool cpass = has_c && b == 0;
        {
#pragma unroll
          for (int s_ = 0; s_ < 2; ++s_) { const int slot = 2 * wave + s_, m = n2_row<L>(b, slot);
              if (m >= 0) { const RowV x = ldrow(X + (size_t)m * D, lane);
                  const float rs = 1.0f / sqrtf(row_ss(x) * (1.f / D) + EPS);
                  RowV h;
#pragma unroll
                  for (int j = 0; j < 4; ++j) h.v[j] = (x.v[j] * rs) * ng.v[j] * (1.f + sc.v[j]) + sh.v[j];
                  strow_bf(H + (size_t)m * D, lane, h);
#pragma unroll
                  for (int j = 0; j < 4; ++j) { unsigned hw0, lw0, hw1, lw1;
                      split_hl2(h.v[j].x, h.v[j].y, hw0, lw0); split_hl2(h.v[j].z, h.v[j].w, hw1, lw1);
                      const int off = slot * 2048 + ((((lane >> 1) + 32 * j) ^ slot) << 4) + 8 * (lane & 1);
                      *(u32x2*)(lds + A_HI + off) = (u32x2){hw0, hw1}; *(u32x2*)(lds + A_LO + off) = (u32x2){lw0, lw1}; } } }
          if (cpass && wave == 7) { const int m = (int)blockIdx.x;
              const RowV sh1 = ldrow(modv + (size_t)(L * 2 + 1) * 6144 + 3072, lane), sc1 = ldrow(modv + (size_t)(L * 2 + 1) * 6144 + 4096, lane);
              const RowV x = ldrow(X + (size_t)m * D, lane);
              const float rs = 1.0f / sqrtf(row_ss(x) * (1.f / D) + EPS);
              RowV h;
#pragma unroll
              for (int j = 0; j < 4; ++j) h.v[j] = (x.v[j] * rs) * ng.v[j] * (1.f + sc1.v[j]) + sh1.v[j];
              strow_bf(H + (size_t)m * D, lane, h);
#pragma unroll
              for (int j = 0; j < 4; ++j) { unsigned hw0, lw0, hw1, lw1;
                  split_hl2(h.v[j].x, h.v[j].y, hw0, lw0); split_hl2(h.v[j].z, h.v[j].w, hw1, lw1);
                  const int off = (((lane >> 1) + 32 * j) << 4) + 8 * (lane & 1);
                  *(u32x2*)(lds + CI_HI + off) = (u32x2){hw0, hw1}; *(u32x2*)(lds + CI_LO + off) = (u32x2){lw0, lw1}; } } }
        __syncthreads();
        { f32x4 acc[3] = {{0.f, 0.f, 0.f, 0.f}, {0.f, 0.f, 0.f, 0.f}, {0.f, 0.f, 0.f, 0.f}};
          const int arow = lane & 15;
#pragma unroll
          for (int ks = 0; ks < 4; ++ks) { const int off = arow * 2048 + (((16 * wave + 4 * ks + (lane >> 4)) ^ arow) << 4);
              const n2_bf16x8 ah = *(const n2_bf16x8*)(lds + A_HI + off), al = *(const n2_bf16x8*)(lds + A_LO + off);
#pragma unroll
              for (int nt = 0; nt < 3; ++nt) { acc[nt] = __builtin_amdgcn_mfma_f32_16x16x32_bf16(ah, Bh[nt][ks], acc[nt], 0, 0, 0);
                  acc[nt] = __builtin_amdgcn_mfma_f32_16x16x32_bf16(al, Bh[nt][ks], acc[nt], 0, 0, 0); acc[nt] = __builtin_amdgcn_mfma_f32_16x16x32_bf16(ah, Bl[nt][ks], acc[nt], 0, 0, 0); } }
          float* part = (float*)(lds + PART) + wave * 16 * 48;
#pragma unroll
          for (int nt = 0; nt < 3; ++nt)
#pragma unroll
              for (int i = 0; i < 4; ++i) part[(4 * (lane >> 4) + i) * 48 + 16 * nt + (lane & 15)] = acc[nt][i]; }
        if (cpass) { f32x4 acc[3] = {{0.f, 0.f, 0.f, 0.f}, {0.f, 0.f, 0.f, 0.f}, {0.f, 0.f, 0.f, 0.f}};
#pragma unroll
          for (int ks = 0; ks < 4; ++ks) { const int off = (16 * wave + 4 * ks + (lane >> 4)) << 4;
              const n2_bf16x8 ah = *(const n2_bf16x8*)(lds + CI_HI + off), al = *(const n2_bf16x8*)(lds + CI_LO + off);
#pragma unroll
              for (int nt = 0; nt < 3; ++nt) { acc[nt] = __builtin_amdgcn_mfma_f32_16x16x32_bf16(ah, Bh[nt][ks], acc[nt], 0, 0, 0);
                  acc[nt] = __builtin_amdgcn_mfma_f32_16x16x32_bf16(al, Bh[nt][ks], acc[nt], 0, 0, 0); acc[nt] = __builtin_amdgcn_mfma_f32_16x16x32_bf16(ah, Bl[nt][ks], acc[nt], 0, 0, 0); } }
          float* cpart = (float*)(lds + CPART) + wave * 48;
          if (lane < 16) {
#pragma unroll
              for (int nt = 0; nt < 3; ++nt) cpart[16 * nt + lane] = acc[nt][0]; } }
        __syncthreads();
#pragma unroll
        for (int s_ = 0; s_ < 2; ++s_) { const int slot = 2 * wave + s_, m = n2_row<L>(b, slot);
            if (m >= 0 && lane < 36) { float v = bias_l[lane];
#pragma unroll
                for (int w = 0; w < 8; ++w) v += ((const float*)(lds + PART))[(w * 16 + slot) * 48 + lane];
                ((float*)(lds + LGA))[(16 * b + slot) * 40 + lane] = v; } }
        if (cpass && wave == 7 && lane < 36) { float v = bias_l[lane];
#pragma unroll
            for (int w = 0; w < 8; ++w) v += ((const float*)(lds + CPART))[w * 48 + lane];
            ((float*)(lds + LGA))[(16 * nbatch) * 40 + lane] = v; }
    }
    __syncthreads();
    int r_m = -1, r_ea = 0, r_eb = 0, r_ra = 0, r_rb = 0;
    if (wave < 2) { const int j = tid;
        if (j < 16 * nbatch) r_m = n2_row<L>(j >> 4, j & 15); else if (j == 16 * nbatch && has_c) r_m = (int)blockIdx.x;
        const int jj = j <= 16 * nbatch ? j : 0;
        route_row((const float*)(lds + LGA) + jj * 40, r_m, cnt_l, rte, rtw, r_m >= 0, r_ea, r_eb, r_ra, r_rb); }
    __syncthreads();
    if (tid < 32) base_l[tid] = atomicAdd(&gcnt[tid], cnt_l[tid]);
    __syncthreads();
    if (r_m >= 0) { const int pa = r_ra + base_l[r_ea], pb = r_rb + base_l[r_eb];
        rtp[r_m * 2] = pa; rtp[r_m * 2 + 1] = pb; list[(size_t)r_ea * LCAP + pa] = r_m; list[(size_t)r_eb * LCAP + pb] = r_m; }
}

template <int L> __device__ __forceinline__ void ph_gather(const P& p, unsigned char* lds) {
    int* ps = (int*)(lds + MISC_OFF + 64);
    const int tid = threadIdx.x, lane = tid & 63, gw = blockIdx.x * 8 + (tid >> 6), ngw = gridDim.x * 8;
    moe_prefix((const int*)(p.ws + WS_CTL) + CW_CNT + L * 32, ps);
    const bf16* H = (const bf16*)(p.ws + WS_H); bf16* XB = (bf16*)(p.ws + WS_XB);
    const int* rte = (const int*)(p.ws + WS_RTE); int* rtp = (int*)(p.ws + WS_RTP);
    for (int m = (L == 3 ? CTX : 0) + gw; m < T; m += ngw) {
        const int d0 = ps[rte[m * 2]] + rtp[m * 2], d1 = ps[rte[m * 2 + 1]] + rtp[m * 2 + 1];
        const u32x4* src = (const u32x4*)(H + (size_t)m * D) + lane; const u32x4 a = src[0], b = src[64];
        u32x4* o0 = (u32x4*)(XB + (size_t)d0 * D) + lane; u32x4* o1 = (u32x4*)(XB + (size_t)d1 * D) + lane;
        o0[0] = a; o0[64] = b; o1[0] = a; o1[64] = b;
        if (lane == 0) { rtp[m * 2] = d0; rtp[m * 2 + 1] = d1; }
    }
}

template <int L> __device__ __forceinline__ void ph_rope(const P& p, unsigned char* lds) {
    constexpr int LD = (L == 0) ? 3072 : 1536, NHQK = (L == 0) ? 32 : 20;
    const int tid = threadIdx.x, lane = tid & 63, gw = blockIdx.x * 8 + (tid >> 6), ngw = gridDim.x * 8;
    bf16* QKV = (bf16*)(p.ws + WS_QKV); const float* rope = (const float*)(p.ws + WS_ROPE);
    unsigned* lmax = (unsigned*)(lds + MISC_OFF + 2560);
    float hmx[2] = {0.f, 0.f};
    if (L == 0) { if (tid < 32) lmax[tid] = 0u; __syncthreads(); }
    for (int m = (int)blockIdx.x + (int)gridDim.x * (tid >> 6); m < T; m += ngw) {
        const bool lat = m >= CTX; const int t = m - CTX, pr = t >> 6, pc = t & 63;
#pragma unroll
        for (int u0 = 0; u0 < NHQK * 4; u0 += 64) {
            const int u = u0 + lane; const bool act = u < NHQK * 4;
            const int head = u >> 2, a = (u >> 1) & 1, ch = u & 1;
            bf16* px = QKV + (size_t)m * LD + head * 64 + a * 32 + ch * 8;
            float x1[8], x2[8];
            if (act) { const u32x4 w1 = *(const u32x4*)px, w2 = *(const u32x4*)(px + 16);
#pragma unroll
                for (int i = 0; i < 4; ++i) { x1[2 * i] = bflo(w1[i]); x1[2 * i + 1] = bfhi(w1[i]); x2[2 * i] = bflo(w2[i]); x2[2 * i + 1] = bfhi(w2[i]); } }
            else {
#pragma unroll
                for (int i = 0; i < 8; ++i) { x1[i] = 0.f; x2[i] = 0.f; } }
            if (L == 2) {
                float ss = 0.f;
#pragma unroll
                for (int i = 0; i < 8; ++i) ss += x1[i] * x1[i] + x2[i] * x2[i];
                ss += __shfl_xor(ss, 1); ss += __shfl_xor(ss, 2);
                const float r = 1.0f / sqrtf(ss * (1.f / 64.f) + EPS);
                const float* gq = p.in[I_CQKN] + (head < 16 ? 0 : 64) + a * 32 + ch * 8;
#pragma unroll
                for (int i = 0; i < 8; ++i) { x1[i] = x1[i] * r * gq[i]; x2[i] = x2[i] * r * gq[16 + i]; }
            }
            if (lat) { const int pos = a == 0 ? pr : pc;
#pragma unroll
                for (int i = 0; i < 8; ++i) { const f32x2 cs = *(const f32x2*)(rope + (size_t)(pos * 16 + ch * 8 + i) * 2);
                    const float y1 = x1[i] * cs.x - x2[i] * cs.y, y2 = x2[i] * cs.x + x1[i] * cs.y; x1[i] = y1; x2[i] = y2; } }
            if (L == 0) {
                float ss = 0.f;
#pragma unroll
                for (int i = 0; i < 8; ++i) ss += x1[i] * x1[i] + x2[i] * x2[i];
                ss += __shfl_xor(ss, 1); ss += __shfl_xor(ss, 2);
                hmx[u0 >> 6] = fmaxf(hmx[u0 >> 6], ss);
            }
            if (L >= 1 && head < 16) {
#pragma unroll
                for (int i = 0; i < 8; ++i) { x1[i] *= 0.125f * 1.4426950408889634f; x2[i] *= 0.125f * 1.4426950408889634f; } }
            if (act && (lat || L >= 1)) { u32x4 w1, w2;
#pragma unroll
                for (int i = 0; i < 4; ++i) { w1[i] = pk2(x1[2 * i], x1[2 * i + 1]); w2[i] = pk2(x2[2 * i], x2[2 * i + 1]); }
                *(u32x4*)px = w1; *(u32x4*)(px + 16) = w2; }
        }
    }
    if (L == 0) {
        if ((lane & 3) == 0) { atomicMax(&lmax[lane >> 2], __float_as_uint(hmx[0])); atomicMax(&lmax[16 + (lane >> 2)], __float_as_uint(hmx[1])); }
        __syncthreads();
        if (tid < 32) atomicMax((unsigned*)(p.ws + WS_CTL) + CW_QKMAX + tid, lmax[tid]);
    }
}

struct NG { const bf16* A; int lda; const float* W; const float* W2; int N, K; size_t wstride; const int* gcnt; int mtiles;
            bf16* C; int ldc; float* X; const float* gate_lat; const float* gate_ctx; int row_off; int pad; };
template <int EPI> __global__ void __launch_bounds__(256) k_ngemm(NG g) {
    __shared__ float As[16][68]; __shared__ float Bs[16][64]; __shared__ float Bs2[16][64]; __shared__ int ps[33];
    const int tid = threadIdx.x, tx = tid & 15, ty = tid >> 4;
    int total_mt = g.mtiles;
    if (g.gcnt) { moe_prefix(g.gcnt, ps); total_mt = ps[32] / 64; }
    const int ntn = g.N / 64;
    for (int tile = blockIdx.x; tile < total_mt * ntn; tile += gridDim.x) {
        const int mt = tile / ntn, nt = tile % ntn;
        const float* W = g.W; const float* W2 = g.W2;
        if (g.gcnt) { int e = 0; while (e < 31 && ps[e + 1] <= mt * 64) ++e; W += (size_t)e * g.wstride; if (EPI == 2) W2 += (size_t)e * g.wstride; }
        float acc[4][4] = {}, acc2[4][4] = {};
        for (int k0 = 0; k0 < g.K; k0 += 16) {
            { const int r = tid >> 2, kc = (tid & 3) * 4; const u32x2 w = *(const u32x2*)(g.A + (size_t)(g.row_off + mt * 64 + r) * g.lda + k0 + kc);
              As[kc][r] = bflo(w.x); As[kc + 1][r] = bfhi(w.x); As[kc + 2][r] = bflo(w.y); As[kc + 3][r] = bfhi(w.y); }
            { const int k = tid >> 4, c = (tid & 15) * 4; *(f32x4*)&Bs[k][c] = *(const f32x4*)(W + (size_t)(k0 + k) * g.N + nt * 64 + c);
              if (EPI == 2) *(f32x4*)&Bs2[k][c] = *(const f32x4*)(W2 + (size_t)(k0 + k) * g.N + nt * 64 + c); }
            __syncthreads();
#pragma unroll
            for (int k = 0; k < 16; ++k) { const f32x4 a = *(const f32x4*)&As[k][ty * 4]; const f32x4 b = *(const f32x4*)&Bs[k][tx * 4];
                f32x4 b2 = {}; if (EPI == 2) b2 = *(const f32x4*)&Bs2[k][tx * 4];
#pragma unroll
                for (int i = 0; i < 4; ++i)
#pragma unroll
                    for (int j = 0; j < 4; ++j) { acc[i][j] += a[i] * b[j]; if (EPI == 2) acc2[i][j] += a[i] * b2[j]; } }
            __syncthreads();
        }
#pragma unroll
        for (int i = 0; i < 4; ++i) { const int row = g.row_off + mt * 64 + ty * 4 + i, col = nt * 64 + tx * 4;
            if (EPI == 0) { u32x2 w; w.x = pk2(acc[i][0], acc[i][1]); w.y = pk2(acc[i][2], acc[i][3]); *(u32x2*)(g.C + (size_t)row * g.ldc + col) = w; }
            else if (EPI == 1) { const float* gt = row < CTX ? g.gate_ctx : g.gate_lat; f32x4* xp = (f32x4*)(g.X + (size_t)row * D + col); f32x4 x = *xp;
#pragma unroll
                for (int j = 0; j < 4; ++j) x[j] += gt[col + j] * acc[i][j];
                *xp = x; }
            else { float h[4];
#pragma unroll
                for (int j = 0; j < 4; ++j) h[j] = silu(acc[i][j]) * acc2[i][j];
                u32x2 w; w.x = pk2(h[0], h[1]); w.y = pk2(h[2], h[3]); *(u32x2*)(g.C + (size_t)row * g.ldc + col) = w; }
        }
    }
}

template <int MODE> __global__ void __launch_bounds__(512) k_nattn(P p) {
    constexpr int LD = (MODE == 0 || MODE == 3) ? 3072 : 1536, NH = MODE == 0 ? 8 : 16, DV = MODE == 0 ? 128 : 64, NSUB = MODE == 0 ? 2 : 1;
    const int tid = threadIdx.x, lane = tid & 63, gw = blockIdx.x * 8 + (tid >> 6), ngw = gridDim.x * 8;
    const bf16* QKV = (const bf16*)(p.ws + WS_QKV); bf16* O = (bf16*)(p.ws + WS_O);
    float* scr = (float*)(p.ws + WS_NSCR) + (size_t)gw * 2 * T;
    const int row0 = MODE == 3 ? CTX : 0;
    const float lam = MODE == 0 ? ((const float*)(p.ws + WS_LAM))[0] : 0.f;
    for (int pair = gw; pair < (T - row0) * NH; pair += ngw) {
        const int m = row0 + pair / NH, h = pair % NH;
        const bool lat = m >= CTX; const int t = m - CTX;
        int ncand = CTX; int r0 = 0, c0 = 0, qr = 0, qc = 0;
        if (lat) { if (MODE == 0 || MODE == 2) ncand = T; else if (MODE == 1) ncand = CTX + 257; else { ncand = CTX + 128; qr = t >> 6; qc = t & 63; r0 = min(max(qr - 4, 0), 248); c0 = min(max(qc - 8, 0), 48); } }
        float outv[2][2]; float Ls[2];
#pragma unroll
        for (int sub = 0; sub < NSUB; ++sub) {
            const int qoff = MODE == 0 ? (2 * h + sub) * 64 : h * 64;
            const int koff = MODE == 0 ? 1024 + (2 * h + sub) * 64 : MODE == 3 ? 1024 + h * 64 : 1024 + (h >> 2) * 64;
            const int voff = MODE == 0 ? 2048 + h * 128 : MODE == 3 ? 2048 + h * 64 : 1280 + (h >> 2) * 64;
            float q[64];
            { const u32x4* qp = (const u32x4*)(QKV + (size_t)m * LD + qoff);
#pragma unroll
              for (int i = 0; i < 8; ++i) { const u32x4 w = qp[i];
#pragma unroll
                  for (int j = 0; j < 4; ++j) { q[i * 8 + 2 * j] = bflo(w[j]); q[i * 8 + 2 * j + 1] = bfhi(w[j]); } } }
            float* sc = scr + sub * T;
            float mx = -INFINITY;
            for (int j = lane; j < ncand; j += 64) {
                int krow = j; float bias = 0.f; bool valid = true;
                if (j >= CTX && lat) {
                    if (MODE == 1) { const int kp = t - 128 + (j - CTX); valid = kp >= 0 && kp < SEQ; krow = CTX + kp; }
                    if (MODE == 3) { const int jj = j - CTX, kr = r0 + (jj >> 4), kc = c0 + (jj & 15); krow = CTX + kr * 64 + kc;
                        bias = p.in[I_DRPB][(h * 15 + (kr - qr + 7)) * 31 + (kc - qc + 15)]; }
                }
                float s = -INFINITY;
                if (valid) { const u32x4* kp = (const u32x4*)(QKV + (size_t)krow * LD + koff); float a = 0.f;
#pragma unroll
                    for (int i = 0; i < 8; ++i) { const u32x4 w = kp[i];
#pragma unroll
                        for (int jq = 0; jq < 4; ++jq) a += q[i * 8 + 2 * jq] * bflo(w[jq]) + q[i * 8 + 2 * jq + 1] * bfhi(w[jq]); }
                    s = a * 0.125f + bias; }
                sc[j] = s; mx = fmaxf(mx, s);
            }
            mx = wave_max(mx);
            float sink = 0.f; if (MODE == 1) { sink = p.in[I_BSINK][h]; mx = fmaxf(mx, sink); }
            float ls = 0.f;
            for (int j = lane; j < ncand; j += 64) { const float e = expf(sc[j] - mx); sc[j] = e; ls += e; }
            ls = wave_sum(ls); if (MODE == 1) ls += expf(sink - mx);
            __threadfence_block();
            float o0 = 0.f, o1 = 0.f;
            for (int j = 0; j < ncand; ++j) {
                int krow = j;
                if (j >= CTX && lat) {
                    if (MODE == 1) { int kp = t - 128 + (j - CTX); kp = min(max(kp, 0), SEQ - 1); krow = CTX + kp; }
                    if (MODE == 3) { const int jj = j - CTX; krow = CTX + (r0 + (jj >> 4)) * 64 + c0 + (jj & 15); }
                }
                const float pj = sc[j]; const bf16* vp = QKV + (size_t)krow * LD + voff;
                o0 += pj * bf2f(vp[lane]); if (DV == 128) o1 += pj * bf2f(vp[64 + lane]);
            }
            outv[sub][0] = o0; outv[sub][1] = o1; Ls[sub] = ls;
            __threadfence_block();
        }
        if (MODE == 0) {
            const float a0 = outv[0][0] / Ls[0] - lam * outv[1][0] / Ls[1], a1 = outv[0][1] / Ls[0] - lam * outv[1][1] / Ls[1];
            const float ss = wave_sum(a0 * a0 + a1 * a1); const float r = 1.0f / sqrtf(ss * (1.f / 128.f) + EPS);
            const float* sg = p.in[I_ASUB];
            O[(size_t)m * D + h * 128 + lane] = (bf16)f2bf(a0 * r * sg[lane] * 0.8f); O[(size_t)m * D + h * 128 + 64 + lane] = (bf16)f2bf(a1 * r * sg[64 + lane] * 0.8f);
        } else O[(size_t)m * D + h * 64 + lane] = (bf16)f2bf(outv[0][0] / Ls[0]);
    }
}


namespace pg8 {
#define PG8_LAS __attribute__((address_space(3)))
typedef unsigned short bf16_t;
typedef short bf16x8 __attribute__((ext_vector_type(8)));
typedef float f32x4 __attribute__((ext_vector_type(4)));
typedef unsigned u32x4 __attribute__((ext_vector_type(4)));
constexpr int BM = 256, BK = 64, HALF = 128, HTB = HALF * BK * 2  , STAGE_BYTES = 8 * HTB, NXCD = 8, WGM = 8;

__host__ __device__ __forceinline__ int lds_byte(int r, int c) { const int st = (r >> 4) * 2 + (c >> 5), rr = r & 15, cc = c & 31, ob = rr * 64 + cc * 2; return st * 1024 + (ob ^ (((ob >> 9) & 1) << 5)); }
__host__ __device__ __forceinline__ void stage_rc(int b, int& R, int& C) { const int st = b / 1024, sb = b % 1024, swz = sb ^ (((sb >> 9) & 1) << 5); R = (st >> 1) * 16 + swz / 64; C = (st & 1) * 32 + (swz % 64) / 2; }
__host__ __device__ __forceinline__ int perm32(int rho) { const int n = rho >> 4, i = rho & 15; return 8 * (i >> 2) + 4 * n + (i & 3); }

struct Unit { int pm, pn, pb; };
struct Gemm { const bf16_t* A; const bf16_t* Bt; int M, N, K; };

struct StaticOrder {
    int nM, nN, nwg, G, c;
    __host__ __device__ void init(int M, int N, int G_, int c_) { nM = M / BM; nN = N / BM; nwg = nM * nN; G = G_; c = c_; }
    __host__ __device__ bool next(int i, Unit& u) const {
        const long L = (long)i * G + c; if (L >= nwg) return false;
        int wgid = (int)L; { const int q = nwg / NXCD, r = nwg % NXCD, xcd = wgid % NXCD, off = wgid / NXCD; wgid = (xcd < r ? xcd * (q + 1) : r * (q + 1) + (xcd - r) * q) + off; }
        const int nig = WGM * nN, gid = wgid / nig, fm = gid * WGM, gsz = (nM - fm) < WGM ? (nM - fm) : WGM;
        u.pm = fm + ((wgid % nig) % gsz); u.pn = (wgid % nig) / gsz; u.pb = u.pn; return true;
    }
    static constexpr bool GATHER = false;
    __device__ __forceinline__ void load_rows(const Unit&, const int (&)[2], const int (&)[2], int, unsigned (&)[2][2]) const {}
    __device__ __forceinline__ void a_ready(const Unit&) const {}
    __device__ __forceinline__ void done(const Unit&) const {}
};

__device__ __forceinline__ unsigned cvt_pk_bf16(float lo, float hi) { unsigned r; asm volatile("v_cvt_pk_bf16_f32 %0, %1, %2" : "=v"(r) : "v"(lo), "v"(hi)); return r; }

template <class Epi, class Sched, bool ALIGN_EPI = false, bool SP2 = false>
__device__ __forceinline__ void gemm_phase(PG8_LAS unsigned char* lds, const Gemm g, const Sched& S, const Epi& E) {
    const int tid = threadIdx.x, wid = __builtin_amdgcn_readfirstlane(tid >> 6), lane = tid & 63, wr = wid >> 2, wc = wid & 3, fr = lane & 15, fq = lane >> 4;
    const int K = g.K, nt = K / BK;
    unsigned voffA[2], voffB[2]; int Rr[2], Cc[2];
#pragma unroll
    for (int i = 0; i < 2; ++i) { int R, C; stage_rc(tid * 16 + i * 8192, R, C); const int Rb = Epi::PERM ? ((R & ~31) + perm32(R & 31)) : R; Rr[i] = R; Cc[i] = C;
        voffA[i] = (unsigned)(R * K + C) * 2u; voffB[i] = (unsigned)(Rb * K + C) * 2u; }
    constexpr bool GATHER = Sched::GATHER;
    unsigned vGc[2][2] = {}, vGn[2][2] = {};
    const size_t kstep = (size_t)(BK * 2);
    const size_t hstep = (size_t)HALF * K * 2;
    const size_t tstep = 2 * hstep;
    const size_t hstepA = GATHER ? 0 : hstep, tstepA = GATHER ? 0 : tstep;
    const unsigned ldsw = (unsigned)wid * 1024u;
    const int aoff = lds_byte(wr * 64 + fr, fq * 8), boff = lds_byte(wc * 32 + fr, fq * 8);
#define PG8_SA(b, h) (((b) * 2 + (h)) * HTB)
#define PG8_SB(b, h) ((4 + (b) * 2 + (h)) * HTB)
#define PG8_STAGE(bufoff, gbase, voff) do { _Pragma("unroll") for (int _i = 0; _i < 2; ++_i) \
        __builtin_amdgcn_global_load_lds((const unsigned*)((const char*)(gbase) + (voff)[_i]), (PG8_LAS unsigned*)(lds + (bufoff) + ldsw + _i * 8192), 16, 0, 0); } while (0)
#define PG8_STAGE_A(bufoff, gbase, h, sel) do { if constexpr (GATHER) { const bool s_ = (sel); unsigned vs_[2] = {s_ ? vGn[h][0] : vGc[h][0], s_ ? vGn[h][1] : vGc[h][1]}; PG8_STAGE(bufoff, gbase, vs_); } else PG8_STAGE(bufoff, gbase, voffA); } while (0)
#define PG8_LDA(dst, b, h) do { _Pragma("unroll") for (int m = 0; m < 4; ++m) _Pragma("unroll") for (int k = 0; k < 2; ++k) dst[m][k] = *(const PG8_LAS bf16x8*)(lds + PG8_SA(b, h) + aoff + m * 2048 + k * 1024); } while (0)
#define PG8_LDB(dst, b, h) do { _Pragma("unroll") for (int n = 0; n < 2; ++n) _Pragma("unroll") for (int k = 0; k < 2; ++k) dst[n][k] = *(const PG8_LAS bf16x8*)(lds + PG8_SB(b, h) + boff + n * 2048 + k * 1024); } while (0)
#define PG8_MMA(ai, bj, At, Bt) do { __builtin_amdgcn_s_setprio(1); _Pragma("unroll") for (int m = 0; m < 4; ++m) _Pragma("unroll") for (int n = 0; n < 2; ++n) _Pragma("unroll") for (int k = 0; k < 2; ++k) \
        acc[ai][bj][m][n] = __builtin_amdgcn_mfma_f32_16x16x32_bf16(Bt[n][k], At[m][k], acc[ai][bj][m][n], 0, 0, 0); __builtin_amdgcn_s_setprio(0); } while (0)
#define PG8_WAIT_V(n) asm volatile("s_waitcnt vmcnt(" #n ")" ::: "memory")
#define PG8_WAIT_L(n) asm volatile("s_waitcnt lgkmcnt(" #n ")" ::: "memory")
#define PG8_BAR __builtin_amdgcn_s_barrier()
#define PG8_SCHED __builtin_amdgcn_sched_barrier(0)
    Unit cur, nxt; int ui = 0;
    if (!S.next(0, cur)) return;
    if constexpr (GATHER) S.load_rows(cur, Rr, Cc, K, vGc);
    f32x4 acc[2][2][4][2];
#pragma unroll
    for (int a = 0; a < 2; ++a)
#pragma unroll
        for (int b = 0; b < 2; ++b)
#pragma unroll
            for (int m = 0; m < 4; ++m)
#pragma unroll
                for (int n = 0; n < 2; ++n) acc[a][b][m][n] = (f32x4){0.f, 0.f, 0.f, 0.f};
    bf16x8 At[4][2], B0[2][2], B1[2][2];
    const char* cA = (const char*)g.A + (size_t)cur.pm * tstepA; const char* cB = (const char*)g.Bt + (size_t)cur.pb * tstep;
    S.a_ready(cur);
    if constexpr (SP2) {
        PG8_STAGE(PG8_SB(0, 0), cB, voffB); PG8_STAGE(PG8_SB(0, 1), cB + hstep, voffB); PG8_STAGE_A(PG8_SA(0, 0), cA, 0, false); PG8_STAGE_A(PG8_SA(0, 1), cA + hstepA, 1, false);
        if (wr == 1) PG8_BAR;
        PG8_WAIT_V(2); PG8_BAR;
        PG8_STAGE(PG8_SB(1, 0), cB + kstep, voffB); PG8_STAGE_A(PG8_SA(1, 0), cA + kstep, 0, false); PG8_STAGE(PG8_SB(1, 1), cB + hstep + kstep, voffB);
        PG8_WAIT_V(6); PG8_BAR;
    } else {
        PG8_STAGE(PG8_SB(0, 0), cB, voffB); PG8_STAGE_A(PG8_SA(0, 0), cA, 0, false); PG8_STAGE(PG8_SB(0, 1), cB + hstep, voffB); PG8_STAGE_A(PG8_SA(0, 1), cA + hstepA, 1, false);
        if (wr == 1) PG8_BAR;
        PG8_WAIT_V(4); PG8_BAR;
        PG8_STAGE(PG8_SB(1, 0), cB + kstep, voffB); PG8_STAGE_A(PG8_SA(1, 0), cA + kstep, 0, false); PG8_STAGE(PG8_SB(1, 1), cB + hstep + kstep, voffB);
        PG8_WAIT_V(6); PG8_BAR;
    }
    for (;;) {
        const bool has_next = S.next(ui + 1, nxt);
        if constexpr (GATHER) { if (has_next) S.load_rows(nxt, Rr, Cc, K, vGn); }
        const char* nA = has_next ? (const char*)g.A + (size_t)nxt.pm * tstepA : cA; const char* nB = has_next ? (const char*)g.Bt + (size_t)nxt.pb * tstep : cB;
        for (int t = 0; t < nt; t += 2) {
            const bool last = (t == nt - 2);
            const char* a1 = cA + (size_t)(t + 1) * kstep;
            const char* a2 = last ? nA : cA + (size_t)(t + 2) * kstep; const char* b2 = last ? nB : cB + (size_t)(t + 2) * kstep;
            const char* a3 = a2 + kstep; const char* b3 = b2 + kstep;
            if (last && has_next) S.a_ready(nxt);
            if constexpr (SP2) {
            PG8_LDB(B0, 0, 0); PG8_LDB(B1, 0, 1); PG8_SCHED; PG8_LDA(At, 0, 0); PG8_STAGE_A(PG8_SA(1, 1), a1 + hstepA, 1, false);
            PG8_WAIT_V(8); PG8_WAIT_L(0); PG8_BAR; PG8_MMA(0, 0, At, B0); PG8_MMA(0, 1, At, B1); PG8_BAR; PG8_SCHED;
            PG8_LDA(At, 0, 1); PG8_STAGE(PG8_SB(0, 0), b2, voffB); PG8_STAGE(PG8_SB(0, 1), b2 + hstep, voffB); PG8_STAGE_A(PG8_SA(0, 0), a2, 0, last && has_next);
            PG8_WAIT_V(8); PG8_WAIT_L(0); PG8_BAR; PG8_MMA(1, 0, At, B0); PG8_MMA(1, 1, At, B1); PG8_BAR; PG8_SCHED;
            PG8_LDB(B0, 1, 0); PG8_LDB(B1, 1, 1); PG8_SCHED; PG8_LDA(At, 1, 0); PG8_STAGE_A(PG8_SA(0, 1), a2 + hstepA, 1, last && has_next);
            PG8_WAIT_V(8); PG8_WAIT_L(0); PG8_BAR; PG8_MMA(0, 0, At, B0); PG8_MMA(0, 1, At, B1); PG8_BAR; PG8_SCHED;
            PG8_LDA(At, 1, 1); PG8_STAGE(PG8_SB(1, 0), b3, voffB); PG8_STAGE(PG8_SB(1, 1), b3 + hstep, voffB); PG8_STAGE_A(PG8_SA(1, 0), a3, 0, last && has_next);
            PG8_WAIT_V(8); PG8_WAIT_L(0); PG8_BAR; PG8_MMA(1, 0, At, B0); PG8_MMA(1, 1, At, B1); PG8_BAR; PG8_SCHED;
            } else {
            PG8_LDB(B0, 0, 0); PG8_SCHED; PG8_LDA(At, 0, 0); PG8_STAGE_A(PG8_SA(1, 1), a1 + hstepA, 1, false);
            PG8_WAIT_L(8); PG8_BAR; PG8_WAIT_L(0); PG8_MMA(0, 0, At, B0); PG8_BAR; PG8_SCHED;
            PG8_LDB(B1, 0, 1); PG8_STAGE(PG8_SB(0, 0), b2, voffB);
            PG8_BAR; PG8_WAIT_L(0); PG8_MMA(0, 1, At, B1); PG8_BAR;
            PG8_LDA(At, 0, 1); PG8_STAGE_A(PG8_SA(0, 0), a2, 0, last && has_next);
            PG8_BAR; PG8_WAIT_L(0); PG8_MMA(1, 0, At, B0); PG8_BAR; PG8_SCHED;
            PG8_STAGE(PG8_SB(0, 1), b2 + hstep, voffB);
            PG8_WAIT_V(6); PG8_BAR; PG8_MMA(1, 1, At, B1); PG8_BAR;
            PG8_LDB(B0, 1, 0); PG8_SCHED; PG8_LDA(At, 1, 0); PG8_STAGE_A(PG8_SA(0, 1), a2 + hstepA, 1, last && has_next);
            PG8_WAIT_L(8); PG8_BAR; PG8_WAIT_L(0); PG8_MMA(0, 0, At, B0); PG8_BAR; PG8_SCHED;
            PG8_LDB(B1, 1, 1); PG8_STAGE(PG8_SB(1, 0), b3, voffB);
            PG8_BAR; PG8_WAIT_L(0); PG8_MMA(0, 1, At, B1); PG8_BAR;
            PG8_LDA(At, 1, 1); PG8_STAGE_A(PG8_SA(1, 0), a3, 0, last && has_next);
            PG8_BAR; PG8_WAIT_L(0); PG8_MMA(1, 0, At, B0); PG8_BAR; PG8_SCHED;
            PG8_STAGE(PG8_SB(1, 1), b3 + hstep, voffB);
            PG8_WAIT_V(6); PG8_BAR; PG8_MMA(1, 1, At, B1); PG8_BAR;
            }
        }
        if constexpr (ALIGN_EPI) { if (wr == 0) PG8_BAR; }
        if constexpr (!Epi::AFTER_DRAIN) { E(acc, cur, wr, wc, fr, fq); S.done(cur); }
        if (!has_next) break;
#pragma unroll
        for (int a = 0; a < 2; ++a)
#pragma unroll
            for (int b = 0; b < 2; ++b)
#pragma unroll
                for (int m = 0; m < 4; ++m)
#pragma unroll
                    for (int n = 0; n < 2; ++n) acc[a][b][m][n] = (f32x4){0.f, 0.f, 0.f, 0.f};
        cur = nxt; cA = nA; cB = nB; ++ui;
        if constexpr (GATHER) { vGc[0][0] = vGn[0][0]; vGc[0][1] = vGn[0][1]; vGc[1][0] = vGn[1][0]; vGc[1][1] = vGn[1][1]; }
        if constexpr (ALIGN_EPI) { if (wr == 1) PG8_BAR; }
    }
    PG8_WAIT_V(0);
    if constexpr (!ALIGN_EPI) { if (wr == 0) PG8_BAR; }
    PG8_BAR;
    if constexpr (Epi::AFTER_DRAIN) { E.fused(acc, cur, wr, wc, fr, fq, lds, wid, lane); S.done(cur); }
#undef PG8_SA
#undef PG8_SB
#undef PG8_STAGE
#undef PG8_STAGE_A
#undef PG8_LDA
#undef PG8_LDB
#undef PG8_MMA
#undef PG8_WAIT_V
#undef PG8_WAIT_L
#undef PG8_BAR
#undef PG8_SCHED
}
}


namespace pg8 {
struct EpiBf16 {
    static constexpr bool PERM = true, AFTER_DRAIN = false;
    bf16_t* O; int ldc; int qtiles = 0; float qscale = 1.f;
    __device__ __forceinline__ void operator()(const f32x4 (&acc)[2][2][4][2], const Unit& u, int wr, int wc, int fr, int fq) const {
        const int row0 = u.pm * BM + wr * 64 + fr, col0 = u.pn * BM + wc * 32 + 8 * fq; const float sc_ = u.pn < qtiles ? qscale : 1.f;
#pragma unroll
        for (int ai = 0; ai < 2; ++ai)
#pragma unroll
            for (int m = 0; m < 4; ++m) { bf16_t* rowp = O + (size_t)(row0 + ai * HALF + m * 16) * ldc + col0;
#pragma unroll
                for (int bj = 0; bj < 2; ++bj) { const f32x4 v0 = acc[ai][bj][m][0] * sc_, v1 = acc[ai][bj][m][1] * sc_;
                    u32x4 w; w.x = cvt_pk_bf16(v0[0], v0[1]); w.y = cvt_pk_bf16(v0[2], v0[3]); w.z = cvt_pk_bf16(v1[0], v1[1]); w.w = cvt_pk_bf16(v1[2], v1[3]);
                    *(u32x4*)(rowp + bj * HALF) = w; } }
    }
};
struct EpiRopeBf16 {
    static constexpr bool PERM = true, AFTER_DRAIN = false;
    bf16_t* O; int ldc; const float* rope; int nrope; int qtiles; float qscale;
    __device__ __forceinline__ void operator()(const f32x4 (&acc)[2][2][4][2], const Unit& u, int wr, int wc, int fr, int fq) const {
        const int row0 = u.pm * BM + wr * 64 + fr, col0 = u.pn * BM + wc * 32 + 8 * fq;
        const bool do_rope = u.pn < nrope && u.pm >= 1;
        const float sc_ = u.pn < qtiles ? qscale : 1.f;
        const int cbase = 8 * (fq & 1); const bool x2side = fq >= 2; const bool colpos = wc & 1;
#pragma unroll
        for (int ai = 0; ai < 2; ++ai)
#pragma unroll
            for (int m = 0; m < 4; ++m) { const int row = row0 + ai * HALF + m * 16; bf16_t* rowp = O + (size_t)row * ldc + col0;
                f32x4 cs[4];
                if (do_rope) { const int t = row - 256, pos = colpos ? (t & 63) : (t >> 6); const f32x4* rp = (const f32x4*)(rope + (size_t)(pos * 16 + cbase) * 2);
#pragma unroll
                    for (int k = 0; k < 4; ++k) cs[k] = rp[k]; }
#pragma unroll
                for (int bj = 0; bj < 2; ++bj) { f32x4 v0 = acc[ai][bj][m][0] * sc_, v1 = acc[ai][bj][m][1] * sc_;
                    if (do_rope) { float e[8] = {v0[0], v0[1], v0[2], v0[3], v1[0], v1[1], v1[2], v1[3]};
#pragma unroll
                        for (int k = 0; k < 8; ++k) { auto rr = __builtin_amdgcn_permlane32_swap(__float_as_uint(e[k]), __float_as_uint(e[k]), false, false);
                            const float pr = __uint_as_float(x2side ? rr[0] : rr[1]); const float c_ = cs[k >> 1][(k & 1) * 2], s_ = cs[k >> 1][(k & 1) * 2 + 1];
                            e[k] = x2side ? e[k] * c_ + pr * s_ : e[k] * c_ - pr * s_; }
                        v0 = (f32x4){e[0], e[1], e[2], e[3]}; v1 = (f32x4){e[4], e[5], e[6], e[7]}; }
                    u32x4 w; w.x = cvt_pk_bf16(v0[0], v0[1]); w.y = cvt_pk_bf16(v0[2], v0[3]); w.z = cvt_pk_bf16(v1[0], v1[1]); w.w = cvt_pk_bf16(v1[2], v1[3]);
                    *(u32x4*)(rowp + bj * HALF) = w; } }
    }
};
struct EpiResid {
    static constexpr bool PERM = false, AFTER_DRAIN = false;
    float* X; const float* gate_lat; const float* gate_ctx; int row_off;
    __device__ __forceinline__ void operator()(const f32x4 (&acc)[2][2][4][2], const Unit& u, int wr, int wc, int fr, int fq) const {
        const int row0 = row_off + u.pm * BM + wr * 64 + fr, col0 = u.pn * BM + wc * 32 + 4 * fq;
        const float* gt = (row_off + u.pm * BM) < 256 ? gate_ctx : gate_lat;
        f32x4 gv[2][2];
#pragma unroll
        for (int bj = 0; bj < 2; ++bj)
#pragma unroll
            for (int n = 0; n < 2; ++n) gv[bj][n] = *(const f32x4*)(gt + col0 + bj * HALF + n * 16);
#pragma unroll
        for (int ai = 0; ai < 2; ++ai)
#pragma unroll
            for (int m = 0; m < 4; ++m) { float* rowp = X + (size_t)(row0 + ai * HALF + m * 16) * 1024 + col0;
#pragma unroll
                for (int bj = 0; bj < 2; ++bj)
#pragma unroll
                    for (int n = 0; n < 2; ++n) { f32x4* xp = (f32x4*)(rowp + bj * HALF + n * 16); *xp = *xp + gv[bj][n] * acc[ai][bj][m][n]; } }
    }
};
struct EpiSilu {
    static constexpr bool PERM = false, AFTER_DRAIN = false;
    bf16_t* Hd;
    __device__ __forceinline__ void operator()(const f32x4 (&acc)[2][2][4][2], const Unit& u, int wr, int wc, int fr, int fq) const {
        const int row0 = u.pm * BM + wr * 64 + fr, col0 = u.pn * 128 + wc * 16 + 4 * fq;
#pragma unroll
        for (int ai = 0; ai < 2; ++ai)
#pragma unroll
            for (int m = 0; m < 4; ++m) { bf16_t* rowp = Hd + (size_t)(row0 + ai * HALF + m * 16) * 512 + col0;
#pragma unroll
                for (int bj = 0; bj < 2; ++bj) { const f32x4 g = acc[ai][bj][m][0], up = acc[ai][bj][m][1]; float h[4];
#pragma unroll
                    for (int i = 0; i < 4; ++i) h[i] = g[i] * __builtin_amdgcn_rcpf(1.f + __expf(-g[i])) * up[i];
                    typedef unsigned u32x2v __attribute__((ext_vector_type(2))); u32x2v w; w.x = cvt_pk_bf16(h[0], h[1]); w.y = cvt_pk_bf16(h[2], h[3]);
                    *(u32x2v*)(rowp + bj * 64) = w; } }
    }
};
template <bool GA> struct MoeOrder {
    static constexpr bool GATHER = GA;
    const PG8_LAS unsigned char* t2e; int ntiles, ntn, G, c;
    const int* list; const PG8_LAS int* psl; const PG8_LAS int* cel; int lcap;
    __device__ __forceinline__ bool next(int i, Unit& u) const {
        const int L = i * G + c; if (L >= ntiles * ntn) return false;
        u.pm = L / ntn; u.pn = L % ntn; u.pb = (int)t2e[u.pm] * ntn + u.pn; return true;
    }
    __device__ __forceinline__ void load_rows(const Unit& u, const int (&Rr)[2], const int (&Cc)[2], int K, unsigned (&vo)[2][2]) const {
        const int e = (int)t2e[u.pm], lb = u.pm * 256 - psl[e], cnt = cel[e]; const int* le = list + (size_t)e * lcap;
#pragma unroll
        for (int h = 0; h < 2; ++h)
#pragma unroll
            for (int i = 0; i < 2; ++i) { const int lr = lb + h * 128 + Rr[i]; const int tok = lr < cnt ? le[lr] : 0; vo[h][i] = (unsigned)(tok * K + Cc[i]) * 2u; }
    }
    __device__ __forceinline__ void a_ready(const Unit&) const {}
    __device__ __forceinline__ void done(const Unit&) const {}
};
}

namespace att {
using bf16x8 = __attribute__((ext_vector_type(8))) short;
using s16x4 = __attribute__((ext_vector_type(4))) short;
using f32x16 = __attribute__((ext_vector_type(16))) float;
constexpr float SCALE = 0.125f, LOG2E = 1.4426950408889634f, C = SCALE * LOG2E, THR = 8.f;
#define ATT_SBAR() __builtin_amdgcn_sched_barrier(0)
__device__ __forceinline__ int crow(int r, int hi) { return (r & 3) + 8 * (r >> 2) + 4 * hi; }
__device__ __forceinline__ unsigned cvtpk(float lo, float hi) { unsigned r; asm volatile("v_cvt_pk_bf16_f32 %0, %1, %2" : "=v"(r) : "v"(lo), "v"(hi)); return r; }
__device__ __forceinline__ int kswz(int row, int colB) { return row * 128 + (colB ^ (((row >> 1) & 7) << 4)); }
template <int DV> __device__ __forceinline__ int v_st(int k, int c) { const int kk = (k & ~0xC) | ((k & 4) << 1) | ((k & 8) >> 1); return ((kk >> 3) * (DV / 32) + (c >> 5)) * 512 + ((kk & 7) * 32 + (c & 31)) * 2; }
__device__ __forceinline__ int v_rd_base(int lane) { return ((lane & 3) << 3) | (((lane >> 2) & 3) << 6) | (((lane >> 4) & 1) << 5) | (((lane >> 5) & 1) << 8); }
template <int DV> constexpr int v_rd_off(int d0, int ks, int half) { return d0 * 512 + ks * (DV / 32) * 1024 + half * (DV / 32) * 512; }
template <int OFF> __device__ __forceinline__ s16x4 tr_read(int vb) { s16x4 r; asm volatile("ds_read_b64_tr_b16 %0, %1 offset:%2" : "=&v"(r) : "v"(vb), "i"(OFF) : "memory"); return r; }

__device__ __forceinline__ void partialSM(f32x16& p0, f32x16& p1, float& m_reg, float& alpha) {
    float pmax = p0[0];
#pragma unroll
    for (int r = 1; r < 16; ++r) pmax = fmaxf(pmax, p0[r]);
#pragma unroll
    for (int r = 0; r < 16; ++r) pmax = fmaxf(pmax, p1[r]);
    { auto rr = __builtin_amdgcn_permlane32_swap(__float_as_uint(pmax), __float_as_uint(pmax), false, false); pmax = fmaxf(__uint_as_float(rr[0]), __uint_as_float(rr[1])); }
    float mn;
    if (__builtin_expect(__all(pmax - m_reg <= THR / SCALE), 1)) { mn = m_reg; alpha = 1.f; }
    else { mn = fmaxf(m_reg, pmax); alpha = __builtin_amdgcn_exp2f((m_reg - mn) * C); m_reg = mn; }
    const float mnC = -mn * C;
#pragma unroll
    for (int r = 0; r < 16; ++r) p0[r] = fmaf(p0[r], C, mnC);
#pragma unroll
    for (int r = 0; r < 16; ++r) p1[r] = fmaf(p1[r], C, mnC);
#pragma unroll
    for (int r = 0; r < 16; ++r) p0[r] = __builtin_amdgcn_exp2f(p0[r]);
}
__device__ __forceinline__ void partialSM_fixed(f32x16& p0, f32x16& p1, float mnC) {
#pragma unroll
    for (int r = 0; r < 16; ++r) p0[r] = fmaf(p0[r], C, mnC);
#pragma unroll
    for (int r = 0; r < 16; ++r) p1[r] = fmaf(p1[r], C, mnC);
#pragma unroll
    for (int r = 0; r < 16; ++r) p0[r] = __builtin_amdgcn_exp2f(p0[r]);
}
__device__ __forceinline__ void finishSM(f32x16& p0, f32x16& p1, float alpha, float& l_reg, bf16x8& pa0, bf16x8& pa1, bf16x8& pa2, bf16x8& pa3) {
#pragma unroll
    for (int r = 0; r < 16; ++r) p1[r] = __builtin_amdgcn_exp2f(p1[r]);
    float ps = 0;
#pragma unroll
    for (int r = 0; r < 16; ++r) ps += p0[r];
#pragma unroll
    for (int r = 0; r < 16; ++r) ps += p1[r];
    { auto rr = __builtin_amdgcn_permlane32_swap(__float_as_uint(ps), __float_as_uint(ps), false, false); ps = __uint_as_float(rr[0]) + __uint_as_float(rr[1]); }
    l_reg = l_reg * alpha + ps;
#define ATT_PK4(P, BASE, OUT) do { unsigned a0 = cvtpk(P[BASE + 0], P[BASE + 1]), a1 = cvtpk(P[BASE + 2], P[BASE + 3]);   \
    unsigned b0 = cvtpk(P[BASE + 4], P[BASE + 5]), b1 = cvtpk(P[BASE + 6], P[BASE + 7]);                              \
    auto r0 = __builtin_amdgcn_permlane32_swap(a0, b0, false, false); auto r1 = __builtin_amdgcn_permlane32_swap(a1, b1, false, false); \
    u32x4 w = {r0[0], r1[0], r0[1], r1[1]}; OUT = *reinterpret_cast<bf16x8*>(&w); } while (0)
    ATT_PK4(p0, 0, pa0); ATT_PK4(p0, 8, pa1); ATT_PK4(p1, 0, pa2); ATT_PK4(p1, 8, pa3);
#undef ATT_PK4
}
__device__ __forceinline__ void qkt(f32x16& p0, f32x16& p1, const char* Ks, const bf16x8* qr, int r32, int hi) {
    p0 = f32x16{}; p1 = f32x16{};
#pragma unroll
    for (int d0 = 0; d0 < 4; ++d0) { const int cb = (d0 * 16 + hi * 8) * 2;
        const bf16x8 b0 = *reinterpret_cast<const bf16x8*>(Ks + kswz(r32, cb));
        const bf16x8 b1 = *reinterpret_cast<const bf16x8*>(Ks + kswz(32 + r32, cb));
        p0 = __builtin_amdgcn_mfma_f32_32x32x16_bf16(b0, qr[d0], p0, 0, 0, 0);
        p1 = __builtin_amdgcn_mfma_f32_32x32x16_bf16(b1, qr[d0], p1, 0, 0, 0); }
}
__device__ __forceinline__ void qkt_init(f32x16& p0, f32x16& p1, const char* Ks, const bf16x8* qr, const f32x16& cinit, int r32, int hi) {
#pragma unroll
    for (int d0 = 0; d0 < 4; ++d0) { const int cb = (d0 * 16 + hi * 8) * 2;
        const bf16x8 b0 = *reinterpret_cast<const bf16x8*>(Ks + kswz(r32, cb));
        const bf16x8 b1 = *reinterpret_cast<const bf16x8*>(Ks + kswz(32 + r32, cb));
        if (d0 == 0) { p0 = __builtin_amdgcn_mfma_f32_32x32x16_bf16(b0, qr[0], cinit, 0, 0, 0); p1 = __builtin_amdgcn_mfma_f32_32x32x16_bf16(b1, qr[0], cinit, 0, 0, 0); }
        else { p0 = __builtin_amdgcn_mfma_f32_32x32x16_bf16(b0, qr[d0], p0, 0, 0, 0); p1 = __builtin_amdgcn_mfma_f32_32x32x16_bf16(b1, qr[d0], p1, 0, 0, 0); } }
}
template <int DV, int D0> __device__ __forceinline__ void pv_one(f32x16& od, int vb, bf16x8 pa0, bf16x8 pa1, bf16x8 pa2, bf16x8 pa3) {
    const s16x4 l0 = tr_read<v_rd_off<DV>(D0, 0, 0)>(vb), h0 = tr_read<v_rd_off<DV>(D0, 0, 1)>(vb), l1 = tr_read<v_rd_off<DV>(D0, 1, 0)>(vb), h1 = tr_read<v_rd_off<DV>(D0, 1, 1)>(vb);
    const s16x4 l2 = tr_read<v_rd_off<DV>(D0, 2, 0)>(vb), h2 = tr_read<v_rd_off<DV>(D0, 2, 1)>(vb), l3 = tr_read<v_rd_off<DV>(D0, 3, 0)>(vb), h3 = tr_read<v_rd_off<DV>(D0, 3, 1)>(vb);
    asm volatile("s_waitcnt lgkmcnt(0)" ::: "memory"); ATT_SBAR();
#define ATT_PK(L, H) (bf16x8){L[0], L[1], L[2], L[3], H[0], H[1], H[2], H[3]}
    od = __builtin_amdgcn_mfma_f32_32x32x16_bf16(pa0, ATT_PK(l0, h0), od, 0, 0, 0);
    od = __builtin_amdgcn_mfma_f32_32x32x16_bf16(pa1, ATT_PK(l1, h1), od, 0, 0, 0);
    od = __builtin_amdgcn_mfma_f32_32x32x16_bf16(pa2, ATT_PK(l2, h2), od, 0, 0, 0);
    od = __builtin_amdgcn_mfma_f32_32x32x16_bf16(pa3, ATT_PK(l3, h3), od, 0, 0, 0);
#undef ATT_PK
}
template <int DV> __device__ __forceinline__ void pv_all(f32x16* o, int vb, bf16x8 pa0, bf16x8 pa1, bf16x8 pa2, bf16x8 pa3) {
    pv_one<DV, 0>(o[0], vb, pa0, pa1, pa2, pa3); pv_one<DV, 1>(o[1], vb, pa0, pa1, pa2, pa3);
    if constexpr (DV == 128) { pv_one<DV, 2>(o[2], vb, pa0, pa1, pa2, pa3); pv_one<DV, 3>(o[3], vb, pa0, pa1, pa2, pa3); }
}
struct VFrag64 { s16x4 l[2][4], h[2][4]; };
__device__ __forceinline__ void vfrag_read64(VFrag64& f, int vb) {
    f.l[0][0] = tr_read<v_rd_off<64>(0, 0, 0)>(vb); f.h[0][0] = tr_read<v_rd_off<64>(0, 0, 1)>(vb); f.l[0][1] = tr_read<v_rd_off<64>(0, 1, 0)>(vb); f.h[0][1] = tr_read<v_rd_off<64>(0, 1, 1)>(vb);
    f.l[0][2] = tr_read<v_rd_off<64>(0, 2, 0)>(vb); f.h[0][2] = tr_read<v_rd_off<64>(0, 2, 1)>(vb); f.l[0][3] = tr_read<v_rd_off<64>(0, 3, 0)>(vb); f.h[0][3] = tr_read<v_rd_off<64>(0, 3, 1)>(vb);
    f.l[1][0] = tr_read<v_rd_off<64>(1, 0, 0)>(vb); f.h[1][0] = tr_read<v_rd_off<64>(1, 0, 1)>(vb); f.l[1][1] = tr_read<v_rd_off<64>(1, 1, 0)>(vb); f.h[1][1] = tr_read<v_rd_off<64>(1, 1, 1)>(vb);
    f.l[1][2] = tr_read<v_rd_off<64>(1, 2, 0)>(vb); f.h[1][2] = tr_read<v_rd_off<64>(1, 2, 1)>(vb); f.l[1][3] = tr_read<v_rd_off<64>(1, 3, 0)>(vb); f.h[1][3] = tr_read<v_rd_off<64>(1, 3, 1)>(vb);
}
__device__ __forceinline__ void pv_frag64(f32x16* o, const VFrag64& f, bf16x8 pa0, bf16x8 pa1, bf16x8 pa2, bf16x8 pa3) {
#define ATT_PK(L, H) (bf16x8){L[0], L[1], L[2], L[3], H[0], H[1], H[2], H[3]}
    o[0] = __builtin_amdgcn_mfma_f32_32x32x16_bf16(pa0, ATT_PK(f.l[0][0], f.h[0][0]), o[0], 0, 0, 0);
    o[1] = __builtin_amdgcn_mfma_f32_32x32x16_bf16(pa0, ATT_PK(f.l[1][0], f.h[1][0]), o[1], 0, 0, 0);
    o[0] = __builtin_amdgcn_mfma_f32_32x32x16_bf16(pa1, ATT_PK(f.l[0][1], f.h[0][1]), o[0], 0, 0, 0);
    o[1] = __builtin_amdgcn_mfma_f32_32x32x16_bf16(pa1, ATT_PK(f.l[1][1], f.h[1][1]), o[1], 0, 0, 0);
    o[0] = __builtin_amdgcn_mfma_f32_32x32x16_bf16(pa2, ATT_PK(f.l[0][2], f.h[0][2]), o[0], 0, 0, 0);
    o[1] = __builtin_amdgcn_mfma_f32_32x32x16_bf16(pa2, ATT_PK(f.l[1][2], f.h[1][2]), o[1], 0, 0, 0);
    o[0] = __builtin_amdgcn_mfma_f32_32x32x16_bf16(pa3, ATT_PK(f.l[0][3], f.h[0][3]), o[0], 0, 0, 0);
    o[1] = __builtin_amdgcn_mfma_f32_32x32x16_bf16(pa3, ATT_PK(f.l[1][3], f.h[1][3]), o[1], 0, 0, 0);
#undef ATT_PK
}
template <int DV> struct Lds { static constexpr int SHM_V = 64 * DV * 2, SHM_K = 8192, V0 = 0, K0 = 2 * SHM_V, WSF = K0 + 2 * SHM_K, STG = WSF + 2048, BIAS = STG + 8 * 32 * DV * 2, END = BIAS + 2048; };

struct MaskP { int mode; int qpos; int kpos0; int qr, qc, r0, c0, rb; const float* bias_l; };
template <int MODE> __device__ __forceinline__ void apply_mask(f32x16& p0, f32x16& p1, int t, const MaskP& mk, int hi) {
    if (MODE == 0 || t < 4) return;
    if (MODE == 1) { const int d0 = mk.kpos0 + 64 * (t - 4) - mk.qpos + 128 + 4 * hi;
#pragma unroll
        for (int r = 0; r < 16; ++r) { const int d = d0 + (r & 3) + 8 * (r >> 2);
            if ((unsigned)d > 256u) p0[r] = -INFINITY; if ((unsigned)(d + 32) > 256u) p1[r] = -INFINITY; } }
    if (MODE == 2) { const int kr = mk.rb + (t - 4);
        if (kr < mk.r0 || kr >= mk.r0 + 8) {
#pragma unroll
            for (int r = 0; r < 16; ++r) { p0[r] = -INFINITY; p1[r] = -INFINITY; } }
        else { const int base = (kr - mk.qr + 7) * 31 - mk.qc + 15 + 4 * hi, dc0 = 4 * hi - mk.c0;
#pragma unroll
            for (int r = 0; r < 16; ++r) { const int kc = (r & 3) + 8 * (r >> 2);
                const bool v0 = (unsigned)(dc0 + kc) < 16u, v1 = (unsigned)(dc0 + kc + 32) < 16u;
                const float b0 = mk.bias_l[v0 ? base + kc : 0], b1 = mk.bias_l[v1 ? base + kc + 32 : 0];
                p0[r] = v0 ? p0[r] + b0 : -INFINITY; p1[r] = v1 ? p1[r] + b1 : -INFINITY;
                if ((r & 3) == 3) asm volatile("" ::: "memory"); } } }
}

template <int DV, int MODE, int SDEPTH = 2>
__device__ __forceinline__ void attn_core(const bf16* __restrict__ QKV, int LD, int qrow0, int qoff, int koff, int voff, int NT, int kbase, const MaskP& mk, char* lds,
                                          f32x16 (&o)[DV / 32], float& l_out, float& m_out) {
    using LM = Lds<DV>;
    const int tid = threadIdx.x, wid = tid >> 6, lane = tid & 63, r32 = lane & 31, hi = lane >> 5;
    char* V_lds = lds + LM::V0; char* K_lds = lds + LM::K0;
    float* al_l = (float*)(lds + LM::WSF) + wid * 64 + 32;
    float m_reg = -1e30f, l_reg = 0.f; bf16x8 qr[4];
#pragma unroll
    for (int d = 0; d < DV / 32; ++d) o[d] = f32x16{};
    const bf16* Qw = QKV + (size_t)(qrow0 + wid * 32 + r32) * LD + qoff + hi * 8;
#pragma unroll
    for (int d0 = 0; d0 < 4; ++d0) qr[d0] = *reinterpret_cast<const bf16x8*>(Qw + d0 * 16);
    const bf16* Kp = QKV + koff; const bf16* Vp = QKV + voff;
    const int ksr = tid >> 3, kc8 = (tid & 7) * 8, kst = kswz(ksr, kc8 * 2);
    const int vsr = DV == 64 ? (tid >> 3) : (tid >> 4), vsc = DV == 64 ? (tid & 7) * 8 : (tid & 15) * 8;
    const int vst0 = v_st<DV>(vsr, vsc), vst1 = v_st<DV>(32 + vsr, vsc);
    const int vb0 = (int)(uintptr_t)V_lds + v_rd_base(lane);
    struct { bf16x8 k, v0, v1; } sr_[SDEPTH];
#define ATT_K0(t) ((t) < 4 ? 64 * (t) : kbase + 64 * ((t) - 4))
#define ATT_SLOAD(i, t) do { const int k0_ = ATT_K0(t); sr_[i].k = *reinterpret_cast<const bf16x8*>(Kp + (size_t)(k0_ + ksr) * LD + kc8); \
    sr_[i].v0 = *reinterpret_cast<const bf16x8*>(Vp + (size_t)(k0_ + vsr) * LD + vsc); \
    if constexpr (DV == 128) sr_[i].v1 = *reinterpret_cast<const bf16x8*>(Vp + (size_t)(k0_ + 32 + vsr) * LD + vsc); } while (0)
#define ATT_SWRITE(b, i) do { *(bf16x8*)(K_lds + (b) * LM::SHM_K + kst) = sr_[i].k; *(bf16x8*)(V_lds + (b) * LM::SHM_V + vst0) = sr_[i].v0; \
    if constexpr (DV == 128) *(bf16x8*)(V_lds + (b) * LM::SHM_V + vst1) = sr_[i].v1; } while (0)
#define ATT_SWAIT() do { if constexpr (SDEPTH == 1) asm volatile("s_waitcnt vmcnt(0)" ::: "memory"); else if constexpr (DV == 128) asm volatile("s_waitcnt vmcnt(3)" ::: "memory"); else asm volatile("s_waitcnt vmcnt(2)" ::: "memory"); } while (0)
#define ATT_RESC(a) do { if (__any((a) < 1.f)) { if (hi == 0) al_l[r32] = (a); asm volatile("s_waitcnt lgkmcnt(0)" ::: "memory"); \
    _Pragma("unroll") for (int d = 0; d < DV / 32; ++d) _Pragma("unroll") for (int r = 0; r < 16; ++r) o[d][r] *= al_l[crow(r, hi)]; } } while (0)
    f32x16 pA0, pA1, pB0, pB1; float alA, alB; bf16x8 pa0, pa1, pa2, pa3;
    constexpr int SE = 0, SO = SDEPTH - 1;
    ATT_SLOAD(SE, 0); asm volatile("s_waitcnt vmcnt(0)" ::: "memory"); ATT_SWRITE(0, SE); __syncthreads();
    qkt(pA0, pA1, K_lds, qr, r32, hi); apply_mask<MODE>(pA0, pA1, 0, mk, hi); partialSM(pA0, pA1, m_reg, alA);
    ATT_SLOAD(SO, 1); if constexpr (SDEPTH == 2) { if (2 < NT) ATT_SLOAD(SE, 2); }
    ATT_SWAIT(); ATT_SWRITE(1, SO); __syncthreads();
    for (int j = 1; j + 1 < NT; j += 2) {
        ATT_SBAR(); qkt(pB0, pB1, K_lds + LM::SHM_K, qr, r32, hi);
        finishSM(pA0, pA1, alA, l_reg, pa0, pa1, pa2, pa3); ATT_SBAR();
        ATT_SLOAD(SO, j + SDEPTH); ATT_SBAR();
        pv_all<DV>(o, vb0, pa0, pa1, pa2, pa3); apply_mask<MODE>(pB0, pB1, j, mk, hi); partialSM(pB0, pB1, m_reg, alB);
        __syncthreads(); ATT_SWAIT(); ATT_SWRITE(0, SE);
        ATT_RESC(alB); __syncthreads();
        ATT_SBAR(); qkt(pA0, pA1, K_lds, qr, r32, hi);
        finishSM(pB0, pB1, alB, l_reg, pa0, pa1, pa2, pa3); ATT_SBAR();
        if (SDEPTH == 1 || j + 3 < NT) ATT_SLOAD(SE, j + 1 + SDEPTH); ATT_SBAR();
        pv_all<DV>(o, vb0 + LM::SHM_V, pa0, pa1, pa2, pa3); apply_mask<MODE>(pA0, pA1, j + 1, mk, hi); partialSM(pA0, pA1, m_reg, alA);
        __syncthreads(); ATT_SWAIT(); ATT_SWRITE(1, SO);
        ATT_RESC(alA); __syncthreads();
    }
    ATT_SBAR(); qkt(pB0, pB1, K_lds + LM::SHM_K, qr, r32, hi);
    finishSM(pA0, pA1, alA, l_reg, pa0, pa1, pa2, pa3); ATT_SBAR();
    pv_all<DV>(o, vb0, pa0, pa1, pa2, pa3); apply_mask<MODE>(pB0, pB1, NT - 1, mk, hi); partialSM(pB0, pB1, m_reg, alB);
    __syncthreads(); ATT_RESC(alB);
    finishSM(pB0, pB1, alB, l_reg, pa0, pa1, pa2, pa3); ATT_SBAR();
    pv_all<DV>(o, vb0 + LM::SHM_V, pa0, pa1, pa2, pa3);
    l_out = l_reg; m_out = m_reg;
#undef ATT_K0
#undef ATT_SLOAD
#undef ATT_SWRITE
#undef ATT_SWAIT
#undef ATT_RESC
}
template <int DV> struct Lds2 { static constexpr int SHM_V = 64 * DV * 2, SHM_K = 8192, K0 = 0, V0 = 3 * SHM_K, WSF = V0 + 3 * SHM_V, STG = WSF + 2048, BIAS = STG + 8 * 32 * DV * 2, END = BIAS + 2048; };
__device__ __forceinline__ void glds16(const void* gsrc, unsigned lds_dst) { unsigned keep;
    asm volatile("s_mov_b32 %0, m0\n\ts_mov_b32 m0, %2\n\ts_nop 0\n\tglobal_load_lds_dwordx4 %1, off\n\ts_mov_b32 m0, %0" : "=&s"(keep) : "v"(gsrc), "s"(lds_dst) : "memory"); }
__device__ __forceinline__ void glds16o(const void* sbase, unsigned voff, unsigned lds_dst) { unsigned keep;
    asm volatile("s_mov_b32 %0, m0\n\ts_mov_b32 m0, %3\n\ts_nop 0\n\tglobal_load_lds_dwordx4 %1, %2\n\ts_mov_b32 m0, %0" : "=&s"(keep) : "v"(voff), "s"(sbase), "s"(lds_dst) : "memory"); }
#define ATT_WAITBAR(N) asm volatile("s_waitcnt vmcnt(" #N ") lgkmcnt(0)\n\ts_barrier" ::: "memory")
template <int DV, int MODE, int FIXM = 0>
__device__ __forceinline__ void attn_core2(const bf16* __restrict__ QKV, int LD, int qrow0, int qoff, int koff, int voff, int NT, int kbase, const MaskP& mk, char* lds,
                                           f32x16 (&o)[DV / 32], float& l_out, float& m_out, float mfix = 0.f) {
    using LM = Lds2<DV>; constexpr int NV = DV / 64;
    const int tid = threadIdx.x, wid = __builtin_amdgcn_readfirstlane(tid >> 6), lane = tid & 63, r32 = lane & 31, hi = lane >> 5;
    const unsigned lds0 = (unsigned)(uintptr_t)lds;
    char* K_lds = lds + LM::K0;
    float* al_l = (float*)(lds + LM::WSF) + wid * 64 + 32;
    float m_reg = FIXM ? mfix : -1e30f, l_reg = 0.f; bf16x8 qr[4]; float mnCf = -mfix * C;
#pragma unroll
    for (int d = 0; d < DV / 32; ++d) o[d] = f32x16{};
    const int krow = 8 * wid + (lane >> 3), kch = (lane & 7) ^ ((krow >> 1) & 7);
    const unsigned ksrc = (unsigned)(krow * LD + kch * 8) * 2u; const bf16* kbase_p = QKV + koff;
    const unsigned kdst = lds0 + LM::K0 + wid * 1024;
    unsigned vsrc0; unsigned vdst0; const bf16* vbase_p = QKV + voff;
    { const int pc = wid, sub = 2 * pc + (lane >> 5), within = lane & 31, kk = (sub / (DV / 32)) * 8 + (within >> 2), cc = (sub % (DV / 32)) * 32 + (within & 3) * 8;
      const int k = (kk & ~0xC) | ((kk & 4) << 1) | ((kk & 8) >> 1);
      vsrc0 = (unsigned)(k * LD + cc) * 2u; vdst0 = lds0 + LM::V0 + pc * 1024; }
#define ATT_K0(t) ((t) < 4 ? 64 * (t) : kbase + 64 * ((t) - 4))
#define ATT_DMA_K(t, slot) glds16o(kbase_p + (size_t)ATT_K0(t) * LD, ksrc, (unsigned)__builtin_amdgcn_readfirstlane(kdst + (slot) * LM::SHM_K))
#define ATT_DMA_V(t, slot) do { _Pragma("unroll") for (int i_ = 0; i_ < NV; ++i_) glds16o(vbase_p + (size_t)(ATT_K0(t) + 32 * i_) * LD, vsrc0, (unsigned)__builtin_amdgcn_readfirstlane(vdst0 + i_ * 8192 + (slot) * LM::SHM_V)); } while (0)
#define ATT_RESC(a) do { if (__any((a) < 1.f)) { if (hi == 0) al_l[r32] = (a); asm volatile("s_waitcnt lgkmcnt(0)" ::: "memory"); \
    _Pragma("unroll") for (int d = 0; d < DV / 32; ++d) _Pragma("unroll") for (int r = 0; r < 16; ++r) o[d][r] *= al_l[crow(r, hi)]; } } while (0)
    const int vb0 = (int)(lds0 + LM::V0) + v_rd_base(lane);
    ATT_DMA_K(0, 0); ATT_DMA_V(0, 0); ATT_DMA_K(1, 1);
    const bf16* Qw = QKV + (size_t)(qrow0 + wid * 32 + r32) * LD + qoff + hi * 8;
#pragma unroll
    for (int d0 = 0; d0 < 4; ++d0) qr[d0] = *reinterpret_cast<const bf16x8*>(Qw + d0 * 16);
    constexpr bool NEGM = (FIXM == 1 && DV == 64);
    f32x16 negm = f32x16{};
    if constexpr (NEGM) {
#pragma unroll
        for (int d0 = 0; d0 < 4; ++d0) { u32x4 w;
#pragma unroll
            for (int j = 0; j < 4; ++j) w[j] = cvtpk(bf2f((unsigned short)qr[d0][2 * j]) * C, bf2f((unsigned short)qr[d0][2 * j + 1]) * C);
            qr[d0] = *reinterpret_cast<bf16x8*>(&w); }
#pragma unroll
        for (int r = 0; r < 16; ++r) negm[r] = mnCf;
        asm volatile("" : "+v"(negm)); }
    if constexpr (FIXM == 2) {
        float qn2 = 0.f;
#pragma unroll
        for (int d0 = 0; d0 < 4; ++d0)
#pragma unroll
            for (int j = 0; j < 8; ++j) { const float v = bf2f((unsigned short)qr[d0][j]); qn2 += v * v; }
        { auto rr = __builtin_amdgcn_permlane32_swap(__float_as_uint(qn2), __float_as_uint(qn2), false, false); qn2 = __uint_as_float(rr[0]) + __uint_as_float(rr[1]); }
        m_reg = sqrtf(qn2) * mfix * (0.125f * 1.01f); mnCf = -m_reg * C; }
    ATT_WAITBAR(0);
    f32x16 pA0, pA1, pB0, pB1; float alA, alB; bf16x8 pa0, pa1, pa2, pa3;
    ATT_DMA_K(2, 2); ATT_DMA_V(1, 1);
    if constexpr (NEGM) { qkt_init(pA0, pA1, K_lds, qr, negm, r32, hi); alA = 1.f; alB = 1.f;
#pragma unroll
        for (int r = 0; r < 16; ++r) pA0[r] = __builtin_amdgcn_exp2f(pA0[r]); }
    else { qkt(pA0, pA1, K_lds, qr, r32, hi); apply_mask<MODE>(pA0, pA1, 0, mk, hi);
        if constexpr (FIXM != 0) { partialSM_fixed(pA0, pA1, mnCf); alA = 1.f; alB = 1.f; } else partialSM(pA0, pA1, m_reg, alA); }
    int s_tm1 = 0, s_t = 1, s_tp1 = 2;
    int w_lo = 0, w_hi = 0;
    if constexpr (MODE == 1) { const int qw = __builtin_amdgcn_readfirstlane(mk.qpos), k0l = __builtin_amdgcn_readfirstlane(mk.kpos0);
        w_lo = (qw - 128 - k0l) >> 6; w_hi = (qw + 31 + 128 - k0l) >> 6; }
    if constexpr (MODE == 2) { const int r0u = __builtin_amdgcn_readfirstlane(mk.r0), rbu = __builtin_amdgcn_readfirstlane(mk.rb); w_lo = r0u - rbu; w_hi = r0u + 7 - rbu; }
#define ATT_ACT(tt) (MODE == 0 || (tt) < 4 || ((tt) - 4 >= w_lo && (tt) - 4 <= w_hi))
#define ATT_STEP(t, PX0, PX1, ALX, ACX, PY0, PY1, ALY, ACY, FULLWAIT, HASK, HASV) do { \
        if (FULLWAIT) ATT_WAITBAR(0); else if constexpr (NV == 1) ATT_WAITBAR(2); else ATT_WAITBAR(3); \
        if (HASK) ATT_DMA_K((t) + 2, s_tm1); if (HASV) ATT_DMA_V((t) + 1, s_tp1); \
        ACX = ATT_ACT(t); \
        ATT_SBAR(); \
        if (ACX) { if constexpr (NEGM) qkt_init(PX0, PX1, K_lds + s_t * LM::SHM_K, qr, negm, r32, hi); else qkt(PX0, PX1, K_lds + s_t * LM::SHM_K, qr, r32, hi); } \
        if (ACY) { finishSM(PY0, PY1, ALY, l_reg, pa0, pa1, pa2, pa3); ATT_SBAR(); \
            pv_all<DV>(o, vb0 + s_tm1 * LM::SHM_V, pa0, pa1, pa2, pa3); } \
        if (ACX) { apply_mask<MODE>(PX0, PX1, (t), mk, hi); \
            if constexpr (NEGM) { _Pragma("unroll") for (int r_ = 0; r_ < 16; ++r_) PX0[r_] = __builtin_amdgcn_exp2f(PX0[r_]); } \
            else if constexpr (FIXM != 0) partialSM_fixed(PX0, PX1, mnCf); else { partialSM(PX0, PX1, m_reg, ALX); ATT_RESC(ALX); } } \
        { const int tmp_ = s_tm1; s_tm1 = s_t; s_t = s_tp1; s_tp1 = tmp_; } } while (0)
    bool acA = true, acB = true;
    int t = 1;
    for (; t <= NT - 5; t += 2) {
        ATT_STEP(t, pB0, pB1, alB, acB, pA0, pA1, alA, acA, false, true, true);
        ATT_STEP(t + 1, pA0, pA1, alA, acA, pB0, pB1, alB, acB, false, true, true);
    }
    ATT_STEP(t, pB0, pB1, alB, acB, pA0, pA1, alA, acA, false, true, true);
    ATT_STEP(t + 1, pA0, pA1, alA, acA, pB0, pB1, alB, acB, false, false, true);
    ATT_STEP(t + 2, pB0, pB1, alB, acB, pA0, pA1, alA, acA, true, false, false);
    if (acB) { finishSM(pB0, pB1, alB, l_reg, pa0, pa1, pa2, pa3); ATT_SBAR();
        pv_all<DV>(o, vb0 + s_tm1 * LM::SHM_V, pa0, pa1, pa2, pa3); }
    asm volatile("s_waitcnt lgkmcnt(0)\n\ts_barrier" ::: "memory");
    l_out = l_reg; m_out = m_reg;
#undef ATT_K0
#undef ATT_DMA_K
#undef ATT_DMA_V
#undef ATT_RESC
#undef ATT_STEP
#undef ATT_ACT
}
__device__ __forceinline__ void bcast_rows(float v, float (&out)[16], char* wsf_base, int wid, int r32, int hi) {
    float* li_l = (float*)wsf_base + wid * 64;
    if (hi == 0) li_l[r32] = v;
    asm volatile("s_waitcnt lgkmcnt(0)" ::: "memory");
#pragma unroll
    for (int r = 0; r < 16; ++r) out[r] = li_l[crow(r, hi)];
    asm volatile("s_waitcnt lgkmcnt(0)" ::: "memory");
}
template <int DV> __device__ __forceinline__ void store_tile(const f32x16 (&o)[DV / 32], bf16* Orow0, char* lds, int wid, int lane) {
    const int r32 = lane & 31, hi = lane >> 5;
    bf16* stg = (bf16*)(lds + Lds2<DV>::STG) + wid * 32 * DV;
#pragma unroll
    for (int r = 0; r < 16; ++r) { const int orow = crow(r, hi);
#pragma unroll
        for (int d0 = 0; d0 < DV / 32; ++d0) stg[orow * DV + d0 * 32 + r32] = (bf16)f2bf(o[d0][r]); }
    asm volatile("s_waitcnt lgkmcnt(0)" ::: "memory");
    constexpr int CPR = DV / 8;
#pragma unroll
    for (int i = 0; i < 32 * CPR / 64; ++i) { const int idx = i * 64 + lane, row = idx / CPR, ch = idx % CPR;
        const u32x4 v = *(const u32x4*)(stg + row * DV + ch * 8); *(u32x4*)(Orow0 + (size_t)row * 1024 + ch * 8) = v; }
    asm volatile("s_waitcnt lgkmcnt(0)" ::: "memory");
}
}

namespace att64 {
using bf16x8=__attribute__((ext_vector_type(8)))short;
using s16x4=__attribute__((ext_vector_type(4)))short;
using f32x16=__attribute__((ext_vector_type(16)))float;
constexpr int D=64,NW=8,QBLK=32,QB=QBLK*NW,KVBLK=64;
__device__ __forceinline__ int crow(int r,int hi){return (r&3)+8*(r>>2)+4*hi;}
#define SBAR() __builtin_amdgcn_sched_barrier(0)
constexpr int NSLOT=3, SLOTB=8192;
constexpr int LDS_K=0, LDS_V=NSLOT*SLOTB, LDS_WS=2*NSLOT*SLOTB, LDS_OST=LDS_WS+NW*64*4, LDS_BIAS=LDS_OST+NW*4096, LDS_BYTES=LDS_BIAS+2048;
constexpr float C2=0.125f*1.4426950408889634f;
__device__ __forceinline__ void glds16(const void*gsrc,unsigned lds_dst){unsigned keep;
  asm volatile("s_mov_b32 %0, m0\n\ts_mov_b32 m0, %2\n\ts_nop 0\n\tglobal_load_lds_dwordx4 %1, off\n\ts_mov_b32 m0, %0":"=&s"(keep):"v"(gsrc),"s"(lds_dst):"memory");}
__device__ __forceinline__ float max3f(float a,float b,float c){float r;asm("v_max3_f32 %0, %1, %2, %3":"=v"(r):"v"(a),"v"(b),"v"(c));return r;}
__device__ __forceinline__ float max2f(float a,float b){float r;asm("v_max_f32_e32 %0, %1, %2":"=v"(r):"v"(a),"v"(b));return r;}
__device__ __forceinline__ float fadd_s(float a,float b){float r;asm("v_add_f32_e32 %0, %1, %2":"=v"(r):"v"(a),"v"(b));return r;}
__device__ __forceinline__ float fsub_s(float a,float b){float r;asm("v_sub_f32_e32 %0, %1, %2":"=v"(r):"v"(a),"v"(b));return r;}
typedef float f32x2_t __attribute__((ext_vector_type(2))); typedef __bf16 bf16x2_t __attribute__((ext_vector_type(2)));
__device__ __forceinline__ unsigned cvtpk_s(float lo,float hi){f32x2_t v={lo,hi};bf16x2_t b=__builtin_convertvector(v,bf16x2_t);return __builtin_bit_cast(unsigned,b);}
#define WAIT_BAR(N) asm volatile("s_waitcnt vmcnt(" #N ") lgkmcnt(0)\n\ts_barrier":::"memory")

__device__ __forceinline__ void qkt(f32x16&p0,f32x16&p1,const char*Kslot,const bf16x8*qr,const f32x16&negm,int r32,int hi){
  const char*kb=Kslot+hi*1024+r32*16;
  #pragma unroll
  for(int d0=0;d0<4;++d0){
    const bf16x8 b0=*reinterpret_cast<const bf16x8*>(kb+d0*2048);
    const bf16x8 b1=*reinterpret_cast<const bf16x8*>(kb+d0*2048+512);
    if(d0==0){p0=__builtin_amdgcn_mfma_f32_32x32x16_bf16(b0,qr[0],negm,0,0,0);p1=__builtin_amdgcn_mfma_f32_32x32x16_bf16(b1,qr[0],negm,0,0,0);}
    else{p0=__builtin_amdgcn_mfma_f32_32x32x16_bf16(b0,qr[d0],p0,0,0,0);p1=__builtin_amdgcn_mfma_f32_32x32x16_bf16(b1,qr[d0],p1,0,0,0);}}
}
typedef __attribute__((address_space(3))) const char* lds_cptr;
typedef short v4i16_t __attribute__((ext_vector_type(4)));
__device__ __forceinline__ void kload8(bf16x8*kf,lds_cptr kp){
  kf[0]=*(const __attribute__((address_space(3))) bf16x8*)(kp);      kf[1]=*(const __attribute__((address_space(3))) bf16x8*)(kp+512);
  kf[2]=*(const __attribute__((address_space(3))) bf16x8*)(kp+2048); kf[3]=*(const __attribute__((address_space(3))) bf16x8*)(kp+2560);
  kf[4]=*(const __attribute__((address_space(3))) bf16x8*)(kp+4096); kf[5]=*(const __attribute__((address_space(3))) bf16x8*)(kp+4608);
  kf[6]=*(const __attribute__((address_space(3))) bf16x8*)(kp+6144); kf[7]=*(const __attribute__((address_space(3))) bf16x8*)(kp+6656);
}
__device__ __forceinline__ void kload2(bf16x8*kf,lds_cptr kp,int j){ kf[2*j]=*(const __attribute__((address_space(3))) bf16x8*)(kp+j*2048); kf[2*j+1]=*(const __attribute__((address_space(3))) bf16x8*)(kp+j*2048+512); }
__device__ __forceinline__ s16x4 vtr(lds_cptr p){ return __builtin_bit_cast(s16x4,__builtin_amdgcn_ds_read_tr16_b64_v4i16((__attribute__((address_space(3))) v4i16_t*)p)); }
__device__ __forceinline__ float rowmax(const f32x16&p0,const f32x16&p1){
  float a=max3f(p0[0],p0[1],p1[0]),b=max3f(p0[2],p0[3],p1[1]);a=max3f(a,p1[2],p1[3]);
  #pragma unroll
  for(int r=4;r<16;r+=4){a=max3f(a,p0[r],p0[r+1]);b=max3f(b,p0[r+2],p0[r+3]);a=max3f(a,p1[r],p1[r+1]);b=max3f(b,p1[r+2],p1[r+3]);}
  const float m=max2f(a,b);
  auto rr=__builtin_amdgcn_permlane32_swap(__float_as_uint(m),__float_as_uint(m),false,false);
  return max2f(__uint_as_float(rr[0]),__uint_as_float(rr[1]));
}
__device__ __forceinline__ void pv(f32x16*o,int vb,bf16x8 pa0,bf16x8 pa1,bf16x8 pa2,bf16x8 pa3){
  #pragma unroll
  for(int d0=0;d0<2;++d0){s16x4 lo[4],hi[4];
    #pragma unroll
    for(int ks=0;ks<4;++ks){
      asm volatile("ds_read_b64_tr_b16 %0,%1 offset:%c2":"=&v"(lo[ks]):"v"(vb),"i"(d0*4096+ks*1024):"memory");
      asm volatile("ds_read_b64_tr_b16 %0,%1 offset:%c2":"=&v"(hi[ks]):"v"(vb),"i"(d0*4096+ks*1024+512):"memory");}
    asm volatile("s_waitcnt lgkmcnt(0)":::"memory");SBAR();
    #define PK(k) (bf16x8){lo[k][0],lo[k][1],lo[k][2],lo[k][3],hi[k][0],hi[k][1],hi[k][2],hi[k][3]}
    o[d0]=__builtin_amdgcn_mfma_f32_32x32x16_bf16(pa0,PK(0),o[d0],0,0,0);
    o[d0]=__builtin_amdgcn_mfma_f32_32x32x16_bf16(pa1,PK(1),o[d0],0,0,0);
    o[d0]=__builtin_amdgcn_mfma_f32_32x32x16_bf16(pa2,PK(2),o[d0],0,0,0);
    o[d0]=__builtin_amdgcn_mfma_f32_32x32x16_bf16(pa3,PK(3),o[d0],0,0,0);
    #undef PK
  }
}

#ifndef ATTN_STORE16
#define ATTN_STORE16(p,v) (*(u32x4*)(p)=(v))
#endif
template<int MODE,int THRL,bool FIXR=false> __device__ __forceinline__ void attn_unit(const bf16*__restrict__ QKV,int LD,int qrow0,int qoff,int koff,int voff,int NT,int kbase,const att::MaskP&mk,bf16*Orow0,char*shm,float sink_l2,float mfix_l2=0.f){
  int tid=threadIdx.x; asm volatile("":"+v"(tid));
  const int lane=tid&63,r32=lane&31,hi=lane>>5; const int wid=__builtin_amdgcn_readfirstlane(tid>>6);
  const bf16*Qw=QKV+(size_t)(qrow0+wid*QBLK)*LD+qoff;
  const bf16*Kh=QKV+koff,*Vh=QKV+voff;
  #define K0T(t) ((t)<4?64*(t):kbase+64*((t)-4))
  const unsigned lds0=(unsigned)(uintptr_t)shm;
  float*wsf=(float*)(shm+LDS_WS)+wid*64;
  const bf16*ksrc=Kh+(long)lane*LD+wid*8;
  const bf16*vsrc=Vh+(long)(16*(wid&3)+(lane>>2))*LD+(wid>>2)*32+(lane&3)*8;
  const unsigned kdst=lds0+LDS_K+wid*1024, vdst=lds0+LDS_V+wid*1024;
  #define DMA_K(t,slot) glds16(ksrc+(long)K0T(t)*LD,(unsigned)__builtin_amdgcn_readfirstlane(kdst+(slot)))
  #define DMA_V(t,slot) glds16(vsrc+(long)K0T(t)*LD,(unsigned)__builtin_amdgcn_readfirstlane(vdst+(slot)))
  const int vb0=(int)(lds0+LDS_V)+((lane>>4)&1)*32+(lane&3)*8+(4*hi+((lane&15)>>2))*64;
  const char*Kbase=shm+LDS_K; bf16x8 kf[8];
  const lds_cptr shm3=(lds_cptr)shm; const lds_cptr kp0=shm3+LDS_K+hi*1024+r32*16; const lds_cptr vp0=shm3+LDS_V+((lane>>4)&1)*32+(lane&3)*8+(4*hi+((lane&15)>>2))*64;
  DMA_K(0,0);DMA_V(0,0);DMA_K(1,SLOTB);
  bf16x8 qr[4];
  #pragma unroll
  for(int d0=0;d0<4;++d0)qr[d0]=*reinterpret_cast<const bf16x8*>(&Qw[(long)r32*LD+d0*16+hi*8]);
  float mhat=FIXR?mfix_l2:0.f,l_reg=0.f;f32x16 o[2];o[0]=f32x16{};o[1]=f32x16{};f32x16 negm;
  { float nz_=-mhat; asm volatile("":"+v"(nz_)); _Pragma("unroll") for(int r=0;r<16;++r)negm[r]=nz_; } asm volatile("":"+v"(negm));
  #define CMASK(P0,P1,t) att::apply_mask<MODE>(P0,P1,(t),mk,hi)
  bool resc=false;
  #define START(P0,P1) do{ resc=false; \
    if constexpr(!FIXR){ const float rm=rowmax(P0,P1); const float dl=rm; mhat=fadd_s(mhat,dl); \
      _Pragma("unroll") for(int r=0;r<16;++r){P0[r]=fsub_s(P0[r],dl);P1[r]=fsub_s(P1[r],dl);} \
      _Pragma("unroll") for(int r=0;r<16;++r)negm[r]=-mhat; asm volatile("":"+v"(negm)); } \
    _Pragma("unroll") for(int r=0;r<16;++r)P0[r]=__builtin_amdgcn_exp2f(P0[r]); }while(0)
  #define RESC() do{ if(resc){ asm volatile("s_waitcnt lgkmcnt(0)":::"memory"); \
      _Pragma("unroll") for(int d_=0;d_<2;++d_) _Pragma("unroll") for(int r=0;r<16;++r)o[d_][r]*=wsf[crow(r,hi)]; } }while(0)
  f32x16 pA0,pA1,pB0,pB1;
  int sl_prev=0,sl_cur=0,sl_next=SLOTB;
  #define ROT() do{sl_prev=sl_cur;sl_cur=sl_next;sl_next=(sl_next==(NSLOT-1)*SLOTB)?0:sl_next+SLOTB;}while(0)
  DMA_K(2,2*SLOTB);
  WAIT_BAR(3);
  qkt(pA0,pA1,Kbase,qr,negm,r32,hi);asm volatile("s_nop 15\n\ts_nop 7":"+v"(pA0),"+v"(pA1));CMASK(pA0,pA1,0);
  START(pA0,pA1);
  _Pragma("unroll") for(int r=0;r<16;++r)pA1[r]=__builtin_amdgcn_exp2f(pA1[r]);
  WAIT_BAR(0);
  DMA_K(3,0);DMA_V(1,SLOTB);
  ROT();
  kload8(kf,kp0+sl_cur);
  WAIT_BAR(2);
  s16x4 vlo[8],vhi[8]; u32x4 pw0,pw1,pw2,pw3;
  #define PKW(P,B) cvtpk_s(P[B],P[B+1])
  #define PAF(k) __builtin_bit_cast(bf16x8,pw##k)
  #define VFR(i) (bf16x8){vlo[i][0],vlo[i][1],vlo[i][2],vlo[i][3],vhi[i][0],vhi[i][1],vhi[i][2],vhi[i][3]}
  #define PIN(x) asm volatile("":"+v"(x))
  #define MX3(a,b,c) __builtin_fmaxf(__builtin_fmaxf((a),(b)),(c))
  #define GAPA(MF,A0,A1,A2,A3,W0,W1,PW) do{ MF; sacc+=A0; sacc+=A1; sacc+=A2; sacc+=A3; PIN(sacc); W0; W1; PIN(PW); SBAR(); }while(0)
  #define EX(v) __builtin_amdgcn_exp2f(v)
  #define GAPB(MF,X,B) do{ MF; X[B]=EX(X[B]); X[B+1]=EX(X[B+1]); X[B+2]=EX(X[B+2]); X[B+3]=EX(X[B+3]); PIN(X); SBAR(); }while(0)
  #define VRD(i) do{ vlo[i]=vtr(vp_+(((i)>>2)*4096+((i)&3)*1024)); vhi[i]=vtr(vp_+(((i)>>2)*4096+((i)&3)*1024+512)); }while(0)
  #define KRD(G,j) do{ if(G){ kload2(kf,kp0+sl_next,j); SBAR(); } }while(0)
  #define STEP(C0,C1,P0,P1,t,GK,GV,GL) do{ SBAR(); \
    const lds_cptr vp_=vp0+sl_prev; \
    VRD(0); SBAR(); float sacc=(P0[0]+P0[1]); \
    GAPA(C0=__builtin_amdgcn_mfma_f32_32x32x16_bf16(kf[0],qr[0],negm,0,0,0), P0[2],P0[3],P0[4],P0[5],     pw0[0]=PKW(P0,0), pw0[1]=PKW(P0,2), pw0); \
    VRD(4); SBAR(); GAPA(C1=__builtin_amdgcn_mfma_f32_32x32x16_bf16(kf[1],qr[0],negm,0,0,0), P0[6],P0[7],P0[8],P0[9],     pw0[2]=PKW(P0,4), pw0[3]=PKW(P0,6), pw0); \
    VRD(1); SBAR(); GAPA(C0=__builtin_amdgcn_mfma_f32_32x32x16_bf16(kf[2],qr[1],C0,0,0,0),   P0[10],P0[11],P0[12],P0[13], pw1[0]=PKW(P0,8), pw1[1]=PKW(P0,10), pw1); \
    VRD(5); SBAR(); GAPA(C1=__builtin_amdgcn_mfma_f32_32x32x16_bf16(kf[3],qr[1],C1,0,0,0),   P0[14],P0[15],P1[0],P1[1],   pw1[2]=PKW(P0,12),pw1[3]=PKW(P0,14), pw1); \
    VRD(2); SBAR(); GAPA(C0=__builtin_amdgcn_mfma_f32_32x32x16_bf16(kf[4],qr[2],C0,0,0,0),   P1[2],P1[3],P1[4],P1[5],     pw2[0]=PKW(P1,0), pw2[1]=PKW(P1,2), pw2); \
    VRD(6); SBAR(); GAPA(C1=__builtin_amdgcn_mfma_f32_32x32x16_bf16(kf[5],qr[2],C1,0,0,0),   P1[6],P1[7],P1[8],P1[9],     pw2[2]=PKW(P1,4), pw2[3]=PKW(P1,6), pw2); \
    VRD(3); SBAR(); GAPA(C0=__builtin_amdgcn_mfma_f32_32x32x16_bf16(kf[6],qr[3],C0,0,0,0),   P1[10],P1[11],P1[12],P1[13], pw3[0]=PKW(P1,8), pw3[1]=PKW(P1,10), pw3); \
    VRD(7); SBAR(); GAPA(C1=__builtin_amdgcn_mfma_f32_32x32x16_bf16(kf[7],qr[3],C1,0,0,0),   P1[14],P1[15],0.f,0.f,       pw3[2]=PKW(P1,12),pw3[3]=PKW(P1,14), pw3); \
    l_reg+=sacc; \
    if(GK){DMA_K((t)+3,sl_cur);} if(GV){DMA_V((t)+1,sl_next);} \
    CMASK(C0,C1,t); \
    if constexpr(!FIXR){ float a=MX3(C0[0],C0[1],C1[0]),b=MX3(C0[2],C0[3],C1[1]); a=MX3(a,C1[2],C1[3]); \
      _Pragma("unroll") for(int r=4;r<16;r+=4){a=MX3(a,C0[r],C0[r+1]);b=MX3(b,C0[r+2],C0[r+3]);a=MX3(a,C1[r],C1[r+1]);b=MX3(b,C1[r+2],C1[r+3]);} \
      float rm=__builtin_fmaxf(a,b); { auto rr=__builtin_amdgcn_permlane32_swap(__float_as_uint(rm),__float_as_uint(rm),false,false); rm=__builtin_fmaxf(__uint_as_float(rr[0]),__uint_as_float(rr[1])); } \
      resc=false; \
      if(__builtin_expect(__any(rm>(float)THRL),0)){ const float dl=__builtin_fmaxf(rm,0.f); mhat+=dl; \
        _Pragma("unroll") for(int r=0;r<16;++r){C0[r]-=dl;C1[r]-=dl;} \
        _Pragma("unroll") for(int r=0;r<16;++r)negm[r]=-mhat; asm volatile("":"+v"(negm)); \
        const float f=__builtin_amdgcn_exp2f(-dl); l_reg*=f; if(hi==0)wsf[r32]=f; resc=true; } } \
    SBAR(); \
    GAPB(o[0]=__builtin_amdgcn_mfma_f32_32x32x16_bf16(PAF(0),VFR(0),o[0],0,0,0), C0,0); \
    GAPB(o[1]=__builtin_amdgcn_mfma_f32_32x32x16_bf16(PAF(0),VFR(4),o[1],0,0,0), C0,4); \
    KRD(GL,0); GAPB(o[0]=__builtin_amdgcn_mfma_f32_32x32x16_bf16(PAF(1),VFR(1),o[0],0,0,0), C0,8); \
    KRD(GL,1); GAPB(o[1]=__builtin_amdgcn_mfma_f32_32x32x16_bf16(PAF(1),VFR(5),o[1],0,0,0), C0,12); \
    KRD(GL,2); GAPB(o[0]=__builtin_amdgcn_mfma_f32_32x32x16_bf16(PAF(2),VFR(2),o[0],0,0,0), C1,0); \
    KRD(GL,3); GAPB(o[1]=__builtin_amdgcn_mfma_f32_32x32x16_bf16(PAF(2),VFR(6),o[1],0,0,0), C1,4); \
    GAPB(o[0]=__builtin_amdgcn_mfma_f32_32x32x16_bf16(PAF(3),VFR(3),o[0],0,0,0), C1,8); \
    GAPB(o[1]=__builtin_amdgcn_mfma_f32_32x32x16_bf16(PAF(3),VFR(7),o[1],0,0,0), C1,12); \
    }while(0)
  int t=1;
  for(;t+5<NT;t+=2){
    STEP(pB0,pB1,pA0,pA1,t,true,true,true);     WAIT_BAR(2); RESC(); ROT();
    STEP(pA0,pA1,pB0,pB1,t+1,true,true,true);   WAIT_BAR(2); RESC(); ROT();
  }
  #define ENDW(tt) do{ if((tt)+3<NT){WAIT_BAR(2);} else if((tt)+2<NT){WAIT_BAR(1);} else {WAIT_BAR(0);} }while(0)
  for(;t+1<NT;t+=2){
    STEP(pB0,pB1,pA0,pA1,t,(t+3<NT),(t+1<NT),(t+1<NT));       ENDW(t);   RESC(); ROT();
    STEP(pA0,pA1,pB0,pB1,t+1,(t+4<NT),(t+2<NT),(t+2<NT));     ENDW(t+1); RESC(); ROT();
  }
  STEP(pB0,pB1,pA0,pA1,NT-1,false,false,false); RESC();
  { float sacc=pB0[0]+pB0[1]; _Pragma("unroll") for(int r=2;r<16;++r)sacc+=pB0[r]; _Pragma("unroll") for(int r=0;r<16;++r)sacc+=pB1[r]; l_reg+=sacc;
    pw0=(u32x4){PKW(pB0,0),PKW(pB0,2),PKW(pB0,4),PKW(pB0,6)};pw1=(u32x4){PKW(pB0,8),PKW(pB0,10),PKW(pB0,12),PKW(pB0,14)};pw2=(u32x4){PKW(pB1,0),PKW(pB1,2),PKW(pB1,4),PKW(pB1,6)};pw3=(u32x4){PKW(pB1,8),PKW(pB1,10),PKW(pB1,12),PKW(pB1,14)};
    SBAR(); pv(o,vb0+sl_cur,PAF(0),PAF(1),PAF(2),PAF(3)); }
  #undef PKW
  #undef PAF
  #undef VFR
  #undef PIN
  #undef MX3
  #undef GAPA
  #undef GAPB
  #undef EX
  #undef VRD
  #undef KRD
  #undef STEP
  #undef ENDW
  {auto rr=__builtin_amdgcn_permlane32_swap(__float_as_uint(l_reg),__float_as_uint(l_reg),false,false);l_reg=__uint_as_float(rr[0])+__uint_as_float(rr[1]);}
  if(MODE==1)l_reg+=__builtin_amdgcn_exp2f(sink_l2-mhat);
  if(hi==0)wsf[32+r32]=l_reg;asm volatile("s_waitcnt lgkmcnt(0)":::"memory");
  float rli[16];
  #pragma unroll
  for(int r=0;r<16;++r)rli[r]=__builtin_amdgcn_rcpf(wsf[32+crow(r,hi)]);
  bf16*Ow=Orow0+(size_t)(wid*QBLK)*1024;
  { bf16*stg=(bf16*)(shm+LDS_OST)+wid*2048;
    #pragma unroll
    for(int r=0;r<16;++r){const int orow=crow(r,hi);
      #pragma unroll
      for(int d0=0;d0<2;++d0)stg[orow*64+d0*32+r32]=(bf16)f2bf(o[d0][r]*rli[r]);}
    asm volatile("s_waitcnt lgkmcnt(0)":::"memory");
    #pragma unroll
    for(int i=0;i<4;++i){const int row=i*8+(lane>>3),ch=lane&7; const u32x4 v=*(const u32x4*)(stg+row*64+ch*8); ATTN_STORE16(Ow+(long)row*1024+ch*8,v);} }
  asm volatile("s_waitcnt lgkmcnt(0)\n\ts_barrier":::"memory");
  #undef DMA_K
  #undef DMA_V
  #undef CMASK
  #undef START
  #undef RESC
  #undef ROT
}
#undef K0T

__device__ __forceinline__ void core128h(int tid,const bf16*__restrict__ QKV,int LD,int qrow0,int qoff,int koff,int voff,int NT,int kbase,char*shm,f32x16(&o)[4],float&l_out){
  constexpr int SLOTV=16384, L_K=0, L_V=NSLOT*SLOTB;
  const int lane=tid&63,r32=lane&31,hi=lane>>5; const int wid=__builtin_amdgcn_readfirstlane(tid>>6);
  const bf16*Qw=QKV+(size_t)(qrow0+wid*QBLK)*LD+qoff;
  const bf16*Kh=QKV+koff,*Vh=QKV+voff;
  #define K0T(t) ((t)<4?64*(t):kbase+64*((t)-4))
  const unsigned lds0=(unsigned)(uintptr_t)shm;
  const bf16*ksrc=Kh+(long)lane*LD+wid*8;
  const bf16*vsrc=Vh+(long)(16*(wid&3)+(lane>>2))*LD+(wid>>2)*32+(lane&3)*8;
  const unsigned kdst=lds0+L_K+wid*1024, vdst=lds0+L_V+wid*1024;
  #define DMA_K(t,slot) glds16(ksrc+(long)K0T(t)*LD,(unsigned)__builtin_amdgcn_readfirstlane(kdst+(slot)))
  #define DMA_V(t,slot) do{ glds16(vsrc+(long)K0T(t)*LD,(unsigned)__builtin_amdgcn_readfirstlane(vdst+2*(slot))); glds16(vsrc+(long)K0T(t)*LD+64,(unsigned)__builtin_amdgcn_readfirstlane(vdst+2*(slot)+8192)); }while(0)
  const int vb0=(int)(lds0+L_V)+((lane>>4)&1)*32+(lane&3)*8+(4*hi+((lane&15)>>2))*64;
  const char*Kbase=shm+L_K; bf16x8 kf[8];
  const lds_cptr shm3=(lds_cptr)shm; const lds_cptr kp0=shm3+L_K+hi*1024+r32*16; const lds_cptr vp0=shm3+L_V+((lane>>4)&1)*32+(lane&3)*8+(4*hi+((lane&15)>>2))*64;
  DMA_K(0,0);DMA_V(0,0);DMA_K(1,SLOTB);
  bf16x8 qr[4];
  #pragma unroll
  for(int d0=0;d0<4;++d0){ const bf16x8 raw=*reinterpret_cast<const bf16x8*>(&Qw[(long)r32*LD+d0*16+hi*8]); u32x4 w;
    #pragma unroll
    for(int j=0;j<4;++j)w[j]=cvtpk_s(bf2f((unsigned short)raw[2*j])*C2,bf2f((unsigned short)raw[2*j+1])*C2);
    qr[d0]=__builtin_bit_cast(bf16x8,w); }
  float l_reg=0.f;
  #pragma unroll
  for(int d=0;d<4;++d)o[d]=f32x16{};
  f32x16 pA0,pA1,pB0,pB1;
  int sl_prev=0,sl_cur=0,sl_next=SLOTB;
  #define ROT() do{sl_prev=sl_cur;sl_cur=sl_next;sl_next=(sl_next==(NSLOT-1)*SLOTB)?0:sl_next+SLOTB;}while(0)
  DMA_K(2,2*SLOTB);
  WAIT_BAR(4);
  { const f32x16 zz=f32x16{}; qkt(pA0,pA1,Kbase,qr,zz,r32,hi); } asm volatile("s_nop 15\n\ts_nop 7":"+v"(pA0),"+v"(pA1));
  _Pragma("unroll") for(int r=0;r<16;++r)pA0[r]=__builtin_amdgcn_exp2f(pA0[r]);
  _Pragma("unroll") for(int r=0;r<16;++r)pA1[r]=__builtin_amdgcn_exp2f(pA1[r]);
  WAIT_BAR(0);
  DMA_K(3,0);DMA_V(1,SLOTB);
  ROT();
  kload8(kf,kp0+sl_cur);
  WAIT_BAR(3);
  s16x4 vlo[4],vhi[4]; u32x4 pw0,pw1,pw2,pw3;
  #define PKW(P,B) cvtpk_s(P[B],P[B+1])
  #define PAF(k) __builtin_bit_cast(bf16x8,pw##k)
  #define VFRN(n) (bf16x8){vlo[(n)&3][0],vlo[(n)&3][1],vlo[(n)&3][2],vlo[(n)&3][3],vhi[(n)&3][0],vhi[(n)&3][1],vhi[(n)&3][2],vhi[(n)&3][3]}
  #define PIN(x) asm volatile("":"+v"(x))
  #define GAPA(MF,A0,A1,A2,A3,W0,W1,PW) do{ MF; sacc+=A0; sacc+=A1; sacc+=A2; sacc+=A3; PIN(sacc); W0; W1; PIN(PW); SBAR(); }while(0)
  #define EX(v) __builtin_amdgcn_exp2f(v)
  #define GAPB2(MF,X,B) do{ MF; X[B]=EX(X[B]); X[B+1]=EX(X[B+1]); PIN(X); SBAR(); }while(0)
  #define VRDN(n) do{ vlo[(n)&3]=vtr(vp_+(((n)&3)*4096+((n)>>2)*1024)); vhi[(n)&3]=vtr(vp_+(((n)&3)*4096+((n)>>2)*1024+512)); SBAR(); }while(0)
  #define KRD(G,j) do{ if(G){ kload2(kf,kp0+sl_next,j); SBAR(); } }while(0)
  #define PVN(n,k,X,B) GAPB2(o[(n)&3]=__builtin_amdgcn_mfma_f32_32x32x16_bf16(PAF(k),VFRN(n),o[(n)&3],0,0,0), X,B)
  #define STEP(C0,C1,P0,P1,t,GK,GV,GL) do{ SBAR(); \
    const lds_cptr vp_=vp0+2*sl_prev; \
    VRDN(0); float sacc=(P0[0]+P0[1]); \
    GAPA(C0=__builtin_amdgcn_mfma_f32_32x32x16_bf16(kf[0],qr[0],f32x16{},0,0,0), P0[2],P0[3],P0[4],P0[5],     pw0[0]=PKW(P0,0), pw0[1]=PKW(P0,2), pw0); \
    GAPA(C1=__builtin_amdgcn_mfma_f32_32x32x16_bf16(kf[1],qr[0],f32x16{},0,0,0), P0[6],P0[7],P0[8],P0[9],     pw0[2]=PKW(P0,4), pw0[3]=PKW(P0,6), pw0); \
    VRDN(1); GAPA(C0=__builtin_amdgcn_mfma_f32_32x32x16_bf16(kf[2],qr[1],C0,0,0,0),   P0[10],P0[11],P0[12],P0[13], pw1[0]=PKW(P0,8), pw1[1]=PKW(P0,10), pw1); \
    GAPA(C1=__builtin_amdgcn_mfma_f32_32x32x16_bf16(kf[3],qr[1],C1,0,0,0),   P0[14],P0[15],P1[0],P1[1],   pw1[2]=PKW(P0,12),pw1[3]=PKW(P0,14), pw1); \
    VRDN(2); GAPA(C0=__builtin_amdgcn_mfma_f32_32x32x16_bf16(kf[4],qr[2],C0,0,0,0),   P1[2],P1[3],P1[4],P1[5],     pw2[0]=PKW(P1,0), pw2[1]=PKW(P1,2), pw2); \
    GAPA(C1=__builtin_amdgcn_mfma_f32_32x32x16_bf16(kf[5],qr[2],C1,0,0,0),   P1[6],P1[7],P1[8],P1[9],     pw2[2]=PKW(P1,4), pw2[3]=PKW(P1,6), pw2); \
    VRDN(3); GAPA(C0=__builtin_amdgcn_mfma_f32_32x32x16_bf16(kf[6],qr[3],C0,0,0,0),   P1[10],P1[11],P1[12],P1[13], pw3[0]=PKW(P1,8), pw3[1]=PKW(P1,10), pw3); \
    GAPA(C1=__builtin_amdgcn_mfma_f32_32x32x16_bf16(kf[7],qr[3],C1,0,0,0),   P1[14],P1[15],0.f,0.f,       pw3[2]=PKW(P1,12),pw3[3]=PKW(P1,14), pw3); \
    l_reg+=sacc; \
    if(GK){DMA_K((t)+3,sl_cur);} if(GV){DMA_V((t)+1,sl_next);} \
    SBAR(); \
    PVN(0,0,C0,0);  VRDN(4);  PVN(1,0,C0,2);  VRDN(5);  PVN(2,0,C0,4);  VRDN(6);  PVN(3,0,C0,6);  VRDN(7); \
    PVN(4,1,C0,8);  VRDN(8);  PVN(5,1,C0,10); VRDN(9);  PVN(6,1,C0,12); VRDN(10); PVN(7,1,C0,14); VRDN(11); \
    PVN(8,2,C1,0);  VRDN(12); PVN(9,2,C1,2);  VRDN(13); KRD(GL,0); PVN(10,2,C1,4); VRDN(14); KRD(GL,1); PVN(11,2,C1,6); VRDN(15); \
    KRD(GL,2); PVN(12,3,C1,8); KRD(GL,3); PVN(13,3,C1,10); PVN(14,3,C1,12); PVN(15,3,C1,14); \
    }while(0)
  int t=1;
  for(;t+5<NT;t+=2){
    STEP(pB0,pB1,pA0,pA1,t,true,true,true);     WAIT_BAR(3); ROT();
    STEP(pA0,pA1,pB0,pB1,t+1,true,true,true);   WAIT_BAR(3); ROT();
  }
  #define ENDW(tt) do{ if((tt)+3<NT){WAIT_BAR(3);} else if((tt)+2<NT){WAIT_BAR(2);} else {WAIT_BAR(0);} }while(0)
  for(;t+1<NT;t+=2){
    STEP(pB0,pB1,pA0,pA1,t,(t+3<NT),(t+1<NT),(t+1<NT));       ENDW(t);   ROT();
    STEP(pA0,pA1,pB0,pB1,t+1,(t+4<NT),(t+2<NT),(t+2<NT));     ENDW(t+1); ROT();
  }
  STEP(pB0,pB1,pA0,pA1,NT-1,false,false,false);
  { float sacc=pB0[0]+pB0[1]; _Pragma("unroll") for(int r=2;r<16;++r)sacc+=pB0[r]; _Pragma("unroll") for(int r=0;r<16;++r)sacc+=pB1[r]; l_reg+=sacc;
    pw0=(u32x4){PKW(pB0,0),PKW(pB0,2),PKW(pB0,4),PKW(pB0,6)};pw1=(u32x4){PKW(pB0,8),PKW(pB0,10),PKW(pB0,12),PKW(pB0,14)};pw2=(u32x4){PKW(pB1,0),PKW(pB1,2),PKW(pB1,4),PKW(pB1,6)};pw3=(u32x4){PKW(pB1,8),PKW(pB1,10),PKW(pB1,12),PKW(pB1,14)};
    SBAR(); pv(o,vb0+2*sl_cur,PAF(0),PAF(1),PAF(2),PAF(3)); pv(o+2,vb0+2*sl_cur+8192,PAF(0),PAF(1),PAF(2),PAF(3)); }
  #undef PKW
  #undef PAF
  #undef VFRN
  #undef PIN
  #undef GAPA
  #undef GAPB2
  #undef EX
  #undef VRDN
  #undef PVN
  #undef KRD
  #undef STEP
  #undef ENDW
  {auto rr=__builtin_amdgcn_permlane32_swap(__float_as_uint(l_reg),__float_as_uint(l_reg),false,false);l_reg=__uint_as_float(rr[0])+__uint_as_float(rr[1]);}
  l_out=l_reg;
  asm volatile("s_waitcnt lgkmcnt(0)\n\ts_barrier":::"memory");
  #undef DMA_K
  #undef DMA_V
  #undef ROT
  #undef K0T
}
#undef SBAR
#undef WAIT_BAR
}


#define GAS __attribute__((address_space(1)))
#define LAS __attribute__((address_space(3)))
#define XB_TMO      128
#define XB_XCNT(j)  (256  + 64 * (j))
#define XB_XSUB(j)  (1280 + 64 * (j))
#define XB_XGEN(j)  (2304 + 64 * (j))
#define XB_TOP      3328
#define XB_TOPGEN   3392
#define XCD_BAR_WORDS 3456
#define XB_SPIN_CAP (1u << 18)
__device__ __forceinline__ unsigned xb_ld(unsigned* p)              { return __hip_atomic_load(p, __ATOMIC_RELAXED, __HIP_MEMORY_SCOPE_AGENT); }
__device__ __forceinline__ unsigned xb_add(unsigned* p, unsigned v) { return __hip_atomic_fetch_add(p, v, __ATOMIC_RELAXED, __HIP_MEMORY_SCOPE_AGENT); }
__device__ __forceinline__ unsigned xb_xcc_id() { return (unsigned)__builtin_amdgcn_s_getreg((3 << 11) | 20) & 0xFu; }
#define XB_SPIN(cond, bar) do { unsigned _sp = 0; while (cond) { __builtin_amdgcn_s_sleep(1); \
    if ((++_sp & 255u) == 0u) { if (xb_ld(&(bar)[XB_TMO])) break; if (_sp > XB_SPIN_CAP) { atomicAdd(&(bar)[XB_TMO], 1u); break; } } } } while (0)
struct XcdBarrier { unsigned* bar; unsigned x; volatile LAS unsigned* st; };
__device__ __forceinline__ XcdBarrier xcd_barrier_post(unsigned* bar, volatile LAS unsigned* st) {
    XcdBarrier b; b.bar = bar; b.x = xb_xcc_id(); b.st = st;
    if (threadIdx.x == 0) (void)xb_add(&bar[XB_XCNT(b.x)], 1u);
    return b;
}
__device__ __forceinline__ void xcd_barrier_complete(unsigned* bar, unsigned x, unsigned& nloc, unsigned& nx) {
    const unsigned G = gridDim.x * gridDim.y * gridDim.z;
    unsigned sum, cnt, mine, sp = 0u;
    for (;;) {
        sum = 0u; cnt = 0u; mine = 0u;
#pragma unroll
        for (unsigned j = 0; j < 16; ++j) { const unsigned c = xb_ld(&bar[XB_XCNT(j)]); sum += c; cnt += (c > 0u) ? 1u : 0u; mine = (j == x) ? c : mine; }
        if (sum == G) break;
        __builtin_amdgcn_s_sleep(1);
        if ((++sp & 255u) == 0u) { if (xb_ld(&bar[XB_TMO])) break; if (sp > XB_SPIN_CAP) { atomicAdd(&bar[XB_TMO], 1u); break; } }
    }
    nloc = mine > 0u ? mine : 1u; nx = cnt > 0u ? cnt : 1u;
}
__device__ __forceinline__ void xcd_barrier(const XcdBarrier& b) {
    asm volatile("s_waitcnt vmcnt(0)" ::: "memory");
    __syncthreads();
    if (threadIdx.x == 0) {
        unsigned* bar = b.bar;
        __builtin_amdgcn_s_waitcnt(0);
        unsigned nloc = b.st[0], nx = b.st[1];
        if (nloc == 0u) { xcd_barrier_complete(bar, b.x, nloc, nx); b.st[0] = nloc; b.st[1] = nx; }
        const unsigned old = xb_add(&bar[XB_XSUB(b.x)], 1u);
        const unsigned gen = old / nloc;
        if (old + 1u == (gen + 1u) * nloc) {
            __builtin_amdgcn_fence(__ATOMIC_RELEASE, "agent");
            asm volatile("s_waitcnt vmcnt(0)" ::: "memory");
            const unsigned og = xb_add(&bar[XB_TOP], 1u);
            const unsigned tgt = (og / nx + 1u) * nx;
            if (og + 1u != tgt) XB_SPIN((int)(xb_ld(&bar[XB_TOP]) - tgt) < 0, bar);
            __builtin_amdgcn_fence(__ATOMIC_ACQUIRE, "agent");
            asm volatile("s_waitcnt vmcnt(0)" ::: "memory");
        } else {
            const unsigned tgt = (gen + 1u) * nx;
            XB_SPIN((int)(xb_ld(&bar[XB_TOP]) - tgt) < 0, bar);
            __builtin_amdgcn_fence(__ATOMIC_ACQUIRE, "agent");
            asm volatile("s_waitcnt vmcnt(0)" ::: "memory");
        }
    }
    __syncthreads();
}

__device__ __forceinline__ void p0_transpose_item(const float* W, int K, int N, bf16* WT, int mode, float* scr, int item, int lane) {
    const int nblk = N / 32, kb = item / nblk, nb = item % nblk, k0 = 64 * kb, n0 = 32 * nb;
#pragma unroll 8
    for (int i = 0; i < 32; ++i) { const int kk = 2 * i + (lane >> 5); scr[kk * 33 + (lane & 31)] = W[(size_t)(k0 + kk) * N + n0 + (lane & 31)]; }
    asm volatile("s_waitcnt lgkmcnt(0)" ::: "memory");
    const int c = lane & 7;
#pragma unroll
    for (int j = 0; j < 4; ++j) { const int n = (lane >> 3) + 8 * j; const float* s = scr + (8 * c) * 33 + n;
        u32x4 o; o.x = pk2(s[0 * 33], s[1 * 33]); o.y = pk2(s[2 * 33], s[3 * 33]); o.z = pk2(s[4 * 33], s[5 * 33]); o.w = pk2(s[6 * 33], s[7 * 33]);
        const int drow = mode == 0 ? n0 + n : 2 * n0 + (n < 16 ? n : n + 16) + (mode == 2 ? 16 : 0);
        *(u32x4*)(WT + (size_t)drow * K + k0 + 8 * c) = o; }
    asm volatile("s_waitcnt lgkmcnt(0)" ::: "memory");
}
constexpr size_t WQKV_OFF[4] = {0, (size_t)3072 * 1024, (size_t)(3072 + 1536) * 1024, (size_t)(3072 + 1536 + 1536) * 1024};
__device__ __forceinline__ bool tail_rank(int nwg, int G, int c, int& rank, int& nranks) {
    const int rem = nwg % G;
    if (rem == 0) { rank = c; nranks = G; return true; }
    if (c < rem) return false;
    rank = c - rem; nranks = G - rem; return true;
}
template <int L> __device__ __forceinline__ void conv_proj(const P& p, unsigned char* lds, int rank, int nranks) {
    constexpr int NQKV = (L == 0 || L == 3) ? 3072 : 1536, NQ = 16 * (NQKV / 32);
    constexpr int IQ = L == 0 ? I_AQKV : L == 1 ? I_BQKV : L == 2 ? I_CQKV : I_DQKV, IO = L == 0 ? I_AWO : L == 1 ? I_BWO : L == 2 ? I_CWO : I_DWO;
    const int wave = threadIdx.x >> 6, lane = threadIdx.x & 63;
    float* scr = (float*)(lds + 16384 + wave * 12288);
    bf16* WQ = (bf16*)(p.ws + WS_WQKV) + WQKV_OFF[L]; bf16* WO = (bf16*)(p.ws + WS_WO) + (size_t)L * 1024 * 1024;
    for (int it = rank * 8 + wave; it < NQ + 512; it += nranks * 8) {
        if (it < NQ) p0_transpose_item(p.in[IQ], 1024, NQKV, WQ, 0, scr, it, lane);
        else p0_transpose_item(p.in[IO], 1024, 1024, WO, 0, scr, it - NQ, lane);
    }
}
constexpr int MOE_ITEMS = 3 * 8192;
template <int L> __device__ __forceinline__ void conv_moe(const P& p, unsigned char* lds, int v0, int v1, int rank, int nranks) {
    const int wave = threadIdx.x >> 6, lane = threadIdx.x & 63;
    float* scr = (float*)(lds + 16384 + wave * 12288);
    bf16* WG = (bf16*)(p.ws + WS_WG); bf16* WD = (bf16*)(p.ws + WS_WD);
    for (int v = v0 + rank * 8 + wave; v < v1; v += nranks * 8) {
        const int kind = v >> 13, r = v & 8191, le = L * 32 + (r >> 8), sub = r & 255;
        if (kind == 0) p0_transpose_item(p.in[I_WGATE] + (size_t)le * 1024 * 512, 1024, 512, WG + (size_t)le * 1024 * 1024, 1, scr, sub, lane);
        else if (kind == 1) p0_transpose_item(p.in[I_WUP] + (size_t)le * 1024 * 512, 1024, 512, WG + (size_t)le * 1024 * 1024, 2, scr, sub, lane);
        else p0_transpose_item(p.in[I_WDOWN] + (size_t)le * 512 * 1024, 512, 1024, WD + (size_t)le * 1024 * 512, 0, scr, sub, lane);
    }
}
constexpr int MV_A = 8576;
constexpr int MV3_B = 13488, MV3_C = 17176;
template <int L, int KIND> __device__ __forceinline__ void tail_conv(const P& p, unsigned char* lds, int rank, int nranks) {
    if constexpr (L == 0 && KIND == 0) conv_moe<0>(p, lds, 0, 7800, rank, nranks);
    if constexpr (L == 0 && KIND == 1) conv_moe<0>(p, lds, 7800, 20296, rank, nranks);
    if constexpr (L == 0 && KIND == 2) { conv_moe<0>(p, lds, 20296, MOE_ITEMS, rank, nranks); conv_proj<1>(p, lds, rank, nranks); conv_moe<1>(p, lds, 0, 4400, rank, nranks); }
    if constexpr (L == 0 && KIND == 3) conv_moe<1>(p, lds, 4400, 9400, rank, nranks);
    if constexpr (L == 1 && KIND == 0) conv_moe<1>(p, lds, 9400, 17200, rank, nranks);
    if constexpr (L == 1 && KIND == 1) { conv_moe<1>(p, lds, 17200, MOE_ITEMS, rank, nranks); conv_proj<2>(p, lds, rank, nranks); conv_moe<2>(p, lds, 0, 3800, rank, nranks); }
    if constexpr (L == 1 && KIND == 2) conv_moe<2>(p, lds, 3800, 13800, rank, nranks);
    if constexpr (L == 1 && KIND == 3) conv_moe<2>(p, lds, 13800, 18800, rank, nranks);
    if constexpr (L == 2 && KIND == 0) { conv_moe<2>(p, lds, 18800, MOE_ITEMS, rank, nranks); conv_proj<3>(p, lds, rank, nranks); }
    if constexpr (L == 2 && KIND == 1) conv_moe<3>(p, lds, 0, 12504, rank, nranks);
    if constexpr (L == 2 && KIND == 2) conv_moe<3>(p, lds, 12504, 22504, rank, nranks);
    if constexpr (L == 2 && KIND == 3) conv_moe<3>(p, lds, 22504, MOE_ITEMS, rank, nranks);
}
__device__ __forceinline__ void ph_weights(const P& p, unsigned char* lds) {
    { float* wrt = (float*)(p.ws + WS_WRT);
      for (int i = blockIdx.x * 512 + threadIdx.x; i < 4 * 36 * 1024; i += gridDim.x * 512) { const int l = i / (36 * 1024), r = i % (36 * 1024), n = r >> 10, k = r & 1023;
          wrt[i] = n < 4 ? p.in[I_RG][(size_t)l * 4096 + k * 4 + n] : p.in[I_RE][(size_t)l * 32768 + k * 32 + n - 4]; } }
    conv_proj<0>(p, lds, (int)blockIdx.x, (int)gridDim.x);
}

#define MK_LDS3(l) ((PG8_LAS unsigned char*)(l))
template <int L> __device__ __forceinline__ void ph_qkv(const P& p, unsigned char* lds) {
    constexpr int NQKV = (L == 0 || L == 3) ? 3072 : 1536;
    pg8::Gemm g{(const bf16*)(p.ws + WS_H), (const bf16*)(p.ws + WS_WQKV) + WQKV_OFF[L], T, NQKV, 1024};
    pg8::StaticOrder S; S.init(T, NQKV, (int)gridDim.x, (int)blockIdx.x);
    if constexpr (L == 1) { pg8::EpiRopeBf16 E{(bf16*)(p.ws + WS_QKV), NQKV, (const float*)(p.ws + WS_ROPE), 5, 4, 0.125f * 1.4426950408889634f};
        pg8::gemm_phase<pg8::EpiRopeBf16, pg8::StaticOrder, true, true>(MK_LDS3(lds), g, S, E);
        int rank, nranks;
        if (tail_rank((T / 256) * (NQKV / 256), (int)gridDim.x, (int)blockIdx.x, rank, nranks)) tail_conv<L, 0>(p, lds, rank, nranks);
        return; }
    pg8::EpiBf16 E{(bf16*)(p.ws + WS_QKV), NQKV, L == 3 ? 4 : 0, 0.125f * 1.4426950408889634f};
    pg8::gemm_phase<pg8::EpiBf16, pg8::StaticOrder, true, true>(MK_LDS3(lds), g, S, E);
    int rank, nranks;
    if (tail_rank((T / 256) * (NQKV / 256), (int)gridDim.x, (int)blockIdx.x, rank, nranks)) tail_conv<L, 0>(p, lds, rank, nranks);
}
template <int L> __device__ __forceinline__ void ph_wo(const P& p, unsigned char* lds) {
    constexpr int ROFF = L == 3 ? CTX : 0, M = T - ROFF;
    const float* modv = (const float*)(p.ws + WS_MODV);
    pg8::Gemm g{(const bf16*)(p.ws + WS_O) + (size_t)ROFF * 1024, (const bf16*)(p.ws + WS_WO) + (size_t)L * 1024 * 1024, M, 1024, 1024};
    pg8::StaticOrder S; S.init(M, 1024, (int)gridDim.x, (int)blockIdx.x);
    pg8::EpiResid E{(float*)(p.ws + WS_X), modv + (size_t)(L * 2) * 6144 + 2048, modv + (size_t)(L * 2 + 1) * 6144 + 2048, ROFF};
    pg8::gemm_phase<pg8::EpiResid, pg8::StaticOrder, true, true>(MK_LDS3(lds), g, S, E);
    int rank, nranks;
    if (tail_rank((M / 256) * 4, (int)gridDim.x, (int)blockIdx.x, rank, nranks)) tail_conv<L, 1>(p, lds, rank, nranks);
}
template <int L> __device__ __forceinline__ int moe_tiles(const P& p, unsigned char* lds) {
    int* ps = (int*)(lds + MISC_OFF + 64); unsigned char* t2e = lds + MISC_OFF + 512; int* ce = (int*)(lds + MISC_OFF + 768);
    __syncthreads();
    const int* gcnt = (const int*)(p.ws + WS_CTL) + CW_CNT + L * 32;
    if (threadIdx.x < 32) ce[threadIdx.x] = gcnt[threadIdx.x];
    moe_prefix(gcnt, ps);
    const int nt = ps[32] >> 8;
    for (int rt = threadIdx.x; rt < nt; rt += 512) { int e = 0; while (e < 31 && ps[e + 1] <= rt * 256) ++e; t2e[rt] = (unsigned char)e; }
    __syncthreads();
    return nt;
}
template <int L> __device__ __forceinline__ void ph_moe1(const P& p, unsigned char* lds) {
    const int nt = moe_tiles<L>(p, lds);
    pg8::Gemm g{(const bf16*)(p.ws + WS_H), (const bf16*)(p.ws + WS_WG) + (size_t)L * 32 * 1024 * 1024, nt * 256, 1024, 1024};
    pg8::MoeOrder<true> S{(const PG8_LAS unsigned char*)(lds + MISC_OFF + 512), nt, 4, (int)gridDim.x, (int)blockIdx.x, (const int*)(p.ws + WS_LIST), (const PG8_LAS int*)(lds + MISC_OFF + 64), (const PG8_LAS int*)(lds + MISC_OFF + 768), LCAP};
    pg8::EpiSilu E{(bf16*)(p.ws + WS_HID)};
    pg8::gemm_phase<pg8::EpiSilu, pg8::MoeOrder<true>, true, true>(MK_LDS3(lds), g, S, E);
    if constexpr (L < 3) { int rank, nranks;
        if (tail_rank(nt * 4, (int)gridDim.x, (int)blockIdx.x, rank, nranks)) tail_conv<L, 2>(p, lds, rank, nranks); }
}
template <int L> __device__ __forceinline__ void ph_moe2(const P& p, unsigned char* lds, bool reuse) {
    const int nt = reuse ? (((const int*)(lds + MISC_OFF + 64))[32] >> 8) : moe_tiles<L>(p, lds);
    pg8::Gemm g{(const bf16*)(p.ws + WS_HID), (const bf16*)(p.ws + WS_WD) + (size_t)L * 32 * 1024 * 512, nt * 256, 1024, 512};
    pg8::MoeOrder<false> S{(const PG8_LAS unsigned char*)(lds + MISC_OFF + 512), nt, 4, (int)gridDim.x, (int)blockIdx.x, nullptr, nullptr, nullptr, 0};
    pg8::EpiBf16 E{(bf16*)(p.ws + WS_YB), 1024};
    pg8::gemm_phase<pg8::EpiBf16, pg8::MoeOrder<false>, true, true>(MK_LDS3(lds), g, S, E);
    if constexpr (L < 3) { int rank, nranks;
        if (tail_rank(nt * 4, (int)gridDim.x, (int)blockIdx.x, rank, nranks)) tail_conv<L, 3>(p, lds, rank, nranks); }
}

template <int FX> __device__ __forceinline__ void diff_units(const P& p, char* lds) {
    using namespace att;
    const bf16* QKV = (const bf16*)(p.ws + WS_QKV); bf16* O = (bf16*)(p.ws + WS_O);
    const float lam = ((const float*)(p.ws + WS_LAM))[0]; const float* sg = p.in[I_ASUB]; const unsigned* qkmax = (const unsigned*)(p.ws + WS_CTL) + CW_QKMAX;
    MaskP mk{};
    for (int u = blockIdx.x; u < 8 * 64 + 8; u += gridDim.x) {
        const bool big = u < 512; const int h = big ? (u & 7) : u - 512, qrow0 = big ? CTX + 256 * (u >> 3) : 0, NT = big ? T / 64 : 4;
        int tidl = threadIdx.x; asm volatile("" : "+v"(tidl));
        const int wid = tidl >> 6, lane = tidl & 63, r32 = lane & 31, hi = lane >> 5;
        f32x16 o[4]; float l, m, rl[16];
#pragma unroll
        for (int sub = 0; sub < 2; ++sub) {
            const int sh_ = 2 * h + sub;
            const float kmaxn = FX ? sqrtf(__uint_as_float(qkmax[16 + sh_])) : 0.f;
            if constexpr (FX == 2) att64::core128h(tidl, QKV, 3072, qrow0, sh_ * 64, 1024 + sh_ * 64, 2048 + h * 128, NT, CTX, lds, o, l);
            else attn_core2<128, 0, FX>(QKV, 3072, qrow0, sh_ * 64, 1024 + sh_ * 64, 2048 + h * 128, NT, CTX, mk, lds, o, l, m, kmaxn);
            bcast_rows(l, rl, lds + Lds2<128>::WSF, wid, r32, hi);
            bf16* stg = (bf16*)(lds + Lds2<128>::STG) + wid * 32 * 128 + (4 * hi) * 128 + r32;
            if (sub == 0) {
#pragma unroll
                for (int r = 0; r < 16; ++r) { const float inv = 1.0f / rl[r];
#pragma unroll
                    for (int d0 = 0; d0 < 4; ++d0) stg[((r & 3) + 8 * (r >> 2)) * 128 + d0 * 32] = (bf16)f2bf(o[d0][r] * inv); }
            } else {
                float sgv[4];
#pragma unroll
                for (int d0 = 0; d0 < 4; ++d0) sgv[d0] = sg[d0 * 32 + r32] * 0.8f;
#pragma unroll
                for (int r = 0; r < 16; ++r) { const float inv = lam / rl[r]; float ss = 0.f;
#pragma unroll
                    for (int d0 = 0; d0 < 4; ++d0) { const float c = bf2f(stg[((r & 3) + 8 * (r >> 2)) * 128 + d0 * 32]) - o[d0][r] * inv; o[d0][r] = c; ss += c * c; }
                    ss += __shfl_xor(ss, 1); ss += __shfl_xor(ss, 2); ss += __shfl_xor(ss, 4); ss += __shfl_xor(ss, 8); ss += __shfl_xor(ss, 16);
                    const float rn = 1.0f / sqrtf(ss * (1.f / 128.f) + EPS);
#pragma unroll
                    for (int d0 = 0; d0 < 4; ++d0) o[d0][r] = o[d0][r] * rn * sgv[d0];
                    asm volatile("" ::: "memory"); }
            }
        }
        store_tile<128>(o, O + (size_t)(qrow0 + wid * 32) * 1024 + h * 128, lds, wid, lane);
    }
}
template <int L> __device__ __forceinline__ void ph_attn(const P& p, unsigned char* lds_) {
    using namespace att;
    char* lds = (char*)lds_;
    const int tid = threadIdx.x, wid = tid >> 6, lane = tid & 63, r32 = lane & 31, hi = lane >> 5;
    const bf16* QKV = (const bf16*)(p.ws + WS_QKV); bf16* O = (bf16*)(p.ws + WS_O);
    MaskP mk{};
    if constexpr (L == 0) {
        const unsigned* qkmax = (const unsigned*)(p.ws + WS_CTL) + CW_QKMAX;
        float gb = 0.f;
        { const int i = lane & 15; gb = wave_max(sqrtf(__uint_as_float(qkmax[i])) * sqrtf(__uint_as_float(qkmax[16 + i]))) * (0.125f * 1.01f); }
        if (gb <= 60.f) diff_units<2>(p, lds); else diff_units<0>(p, lds);
    } else {
        constexpr int MODE = L == 1 ? 1 : L == 3 ? 2 : 0, LD = L == 3 ? 3072 : 1536;
        constexpr int NBIG = 16 * 64, NU = L == 3 ? NBIG : NBIG + 16;
        float* bias_l = (float*)(lds + att64::LDS_BIAS); mk.bias_l = bias_l;
        float mfix = 1e30f;
        if (L == 2) { const float* gq = p.in[I_CQKN]; const float gqm = wave_max(fabsf(gq[lane])), gkm = wave_max(fabsf(gq[64 + lane])); mfix = 8.0f * gqm * gkm * 1.001f; }
        for (int u = blockIdx.x; u < NU; u += gridDim.x) {
            int tidl = threadIdx.x; asm volatile("" : "+v"(tidl));
            const int wid = __builtin_amdgcn_readfirstlane(tidl >> 6), r32 = tidl & 31;
            const bool big = u < NBIG; const int h = big ? (u & 15) : u - NBIG, qbl = u >> 4, qrow0 = big ? CTX + 256 * qbl : 0;
            const int qoff = h * 64, koff = L == 3 ? 1024 + h * 64 : 1024 + (h >> 2) * 64, voff = L == 3 ? 2048 + h * 64 : 1280 + (h >> 2) * 64;
            int NT = big ? T / 64 : 4, kbase = CTX;
            if (L == 1 && big) { const int q0l = 256 * qbl, lo = max(q0l - 128, 0), hi_ = min(q0l + 384, SEQ); NT = 4 + (hi_ - lo) / 64; kbase = CTX + lo; mk.qpos = q0l + wid * 32 + r32; mk.kpos0 = lo; }
            if (L == 3) { const int rlo = min(max(4 * qbl - 4, 0), 248), rhi = min(max(4 * qbl - 1, 0), 248) + 7; int cnt = rhi - rlo + 1; cnt += cnt & 1; NT = 4 + cnt; kbase = CTX + 64 * rlo;
                mk.rb = rlo; mk.qr = 4 * qbl + (wid >> 1); mk.qc = (wid & 1) * 32 + r32; mk.r0 = min(max(mk.qr - 4, 0), 248); mk.c0 = min(max(mk.qc - 8, 0), 48);
                if (tid < 465) bias_l[tid] = p.in[I_DRPB][h * 465 + tid] * LOG2E; }
            if constexpr (L == 3) { att64::attn_unit<2, 8>(QKV, LD, qrow0, qoff, koff, voff, NT, kbase, mk, O + (size_t)qrow0 * 1024 + h * 64, lds, 0.f); continue; }
            if constexpr (L == 1) { att64::attn_unit<1, 8>(QKV, LD, qrow0, qoff, koff, voff, NT, kbase, mk, O + (size_t)qrow0 * 1024 + h * 64, lds, p.in[I_BSINK][h] * LOG2E); continue; }
            if constexpr (L == 2) {
                if (mfix <= 40.f) att64::attn_unit<0, 8, true>(QKV, LD, qrow0, qoff, koff, voff, NT, kbase, mk, O + (size_t)qrow0 * 1024 + h * 64, lds, 0.f, mfix * LOG2E);
                else att64::attn_unit<0, 8>(QKV, LD, qrow0, qoff, koff, voff, NT, kbase, mk, O + (size_t)qrow0 * 1024 + h * 64, lds, 0.f);
                continue; }
            f32x16 o[2]; float l, m, rl[16];
            if (L == 2 && mfix <= 40.f) attn_core2<64, MODE, 1>(QKV, LD, qrow0, qoff, koff, voff, NT, kbase, mk, lds, o, l, m, mfix);
            else attn_core2<64, MODE>(QKV, LD, qrow0, qoff, koff, voff, NT, kbase, mk, lds, o, l, m);
            if (L == 1) l += __builtin_amdgcn_exp2f(p.in[I_BSINK][h] * LOG2E - m * C);
            bcast_rows(l, rl, lds + Lds2<64>::WSF, wid, r32, hi);
#pragma unroll
            for (int r = 0; r < 16; ++r) { const float inv = 1.0f / rl[r]; o[0][r] *= inv; o[1][r] *= inv; }
            store_tile<64>(o, O + (size_t)(qrow0 + wid * 32) * 1024 + h * 64, lds, wid, lane);
        }
    }
}

struct Args { P p; int ph_lo, ph_hi, li, pad; };
constexpr int NPHASE = 38;
typedef const Args __attribute__((address_space(4)))* KArgs;
__device__ __forceinline__ P load_p(KArgs ka) { P p;
#if defined(__HIP_DEVICE_COMPILE__)
    asm volatile("" : "+s"(ka));
#pragma unroll
    for (int i = 0; i < 29; ++i) p.in[i] = ka->p.in[i];
    p.out = ka->p.out; p.ws = ka->p.ws;
#endif
    return p; }
#ifndef MK_REP
#define MK_REP 0ull
#endif
#define REP(k) (((MK_REP) >> (k)) & 1ull)
#define IN(k) (lo <= (k) && (k) < hi)
#define SEAM(k) do { if (IN(k) && IN((k) + 1)) xcd_barrier(bar); } while (0)
template <int L> __device__ __forceinline__ void run_layer_phases(KArgs ka, unsigned char* lds, const XcdBarrier& bar, int lo, int hi) {
    constexpr int B = 1 + 9 * L;
    if (IN(B + 0)) { const P p = load_p(ka); ph_norm1<L>(p, lds); } SEAM(B + 0);
    if (IN(B + 1)) { const P p = load_p(ka); ph_qkv<L>(p, lds); if (REP(B + 1)) { xcd_barrier(bar); ph_qkv<L>(p, lds); } } SEAM(B + 1);
    if (L == 0 || L == 2) { if (IN(B + 2)) { const P p = load_p(ka); ph_rope<L>(p, lds); } SEAM(B + 2); }
    if (IN(B + 3)) { const P p = load_p(ka); ph_attn<L>(p, lds); if (REP(B + 3)) { xcd_barrier(bar); ph_attn<L>(p, lds); } } SEAM(B + 3);
    if (IN(B + 4)) { const P p = load_p(ka); ph_wo<L>(p, lds); } SEAM(B + 4);
    if (IN(B + 5)) { const P p = load_p(ka); ph_norm2<L>(p, lds); } SEAM(B + 5);
    if (IN(B + 7)) { const P p = load_p(ka); ph_moe1<L>(p, lds); if (REP(B + 7)) { xcd_barrier(bar); ph_moe1<L>(p, lds); } } SEAM(B + 7);
    if (IN(B + 8)) { const P p = load_p(ka); ph_moe2<L>(p, lds, IN(B + 7)); if (REP(B + 8)) { xcd_barrier(bar); ph_moe2<L>(p, lds, IN(B + 7)); } } SEAM(B + 8);
}
__global__ void __launch_bounds__(512, 2) mk_fwd(Args a_unused) {
    extern __shared__ __attribute__((aligned(16))) unsigned char lds[];
    KArgs ka = (KArgs)__builtin_amdgcn_kernarg_segment_ptr();
    for (int u = threadIdx.x; u < (LDS_BYTES - MISC_OFF) / 4; u += 512) ((unsigned*)(lds + MISC_OFF))[u] = 0u;
    __syncthreads();
    const XcdBarrier bar = xcd_barrier_post((unsigned*)(ka->p.ws + WS_CTL) + CW_BAR + ka->li * XCD_BAR_WORDS, (volatile LAS unsigned*)(lds + MISC_OFF));
    const int lo = ka->ph_lo, hi = ka->ph_hi;
    if (IN(0)) { const P p = load_p(ka); ph_modvec(p, lds); ph_weights(p, lds); if (REP(0)) { xcd_barrier(bar); ph_weights(p, lds); } } SEAM(0);
    run_layer_phases<0>(ka, lds, bar, lo, hi);
    run_layer_phases<1>(ka, lds, bar, lo, hi);
    run_layer_phases<2>(ka, lds, bar, lo, hi);
    run_layer_phases<3>(ka, lds, bar, lo, hi);
    if (IN(37)) { const P p = load_p(ka); ph_norm1<4>(p, lds); }
}
#undef IN
#undef SEAM
#undef REP

#ifndef MK_NAIVE_ATTN
#define MK_NAIVE_ATTN 0
#endif
#ifndef MK_NAIVE_GEMM
#define MK_NAIVE_GEMM 0
#endif
#ifndef MK_SPLIT_ALL
#define MK_SPLIT_ALL 0
#endif
template <int L> static void naive_phase(const P& p, int sub, hipStream_t stream) {
    constexpr int NQKV = (L == 0 || L == 3) ? 3072 : 1536;
    constexpr int IQ = L == 0 ? I_AQKV : L == 1 ? I_BQKV : L == 2 ? I_CQKV : I_DQKV, IO = L == 0 ? I_AWO : L == 1 ? I_BWO : L == 2 ? I_CWO : I_DWO;
    unsigned char* ws = p.ws; const float* modv = (const float*)(ws + WS_MODV);
    const int* gcnt = (const int*)(ws + WS_CTL) + CW_CNT + L * 32;
    if (sub == 1) { NG g{}; g.A = (const bf16*)(ws + WS_H); g.lda = D; g.W = p.in[IQ]; g.N = NQKV; g.K = D; g.mtiles = T / 64; g.C = (bf16*)(ws + WS_QKV); g.ldc = NQKV;
        hipLaunchKernelGGL(k_ngemm<0>, dim3(2048), dim3(256), 0, stream, g); }
    if (sub == 3) hipLaunchKernelGGL(k_nattn<L>, dim3(160), dim3(512), 0, stream, p);
    if (sub == 4) { NG g{}; g.A = (const bf16*)(ws + WS_O); g.lda = D; g.W = p.in[IO]; g.N = D; g.K = D; g.mtiles = (L == 3 ? SEQ : T) / 64; g.row_off = L == 3 ? CTX : 0; g.X = (float*)(ws + WS_X);
        g.gate_lat = modv + (size_t)(L * 2) * 6144 + 2048; g.gate_ctx = modv + (size_t)(L * 2 + 1) * 6144 + 2048;
        hipLaunchKernelGGL(k_ngemm<1>, dim3(2048), dim3(256), 0, stream, g); }
    if (sub == 7) { NG g{}; g.A = (const bf16*)(ws + WS_XB); g.lda = D; g.W = p.in[I_WGATE] + (size_t)L * 32 * 1024 * 512; g.W2 = p.in[I_WUP] + (size_t)L * 32 * 1024 * 512; g.N = DEXP; g.K = D; g.wstride = (size_t)1024 * 512;
        g.gcnt = gcnt; g.C = (bf16*)(ws + WS_HID); g.ldc = DEXP;
        hipLaunchKernelGGL(k_ngemm<2>, dim3(2048), dim3(256), 0, stream, g); }
    if (sub == 8) { NG g{}; g.A = (const bf16*)(ws + WS_HID); g.lda = DEXP; g.W = p.in[I_WDOWN] + (size_t)L * 32 * 512 * 1024; g.N = D; g.K = DEXP; g.wstride = (size_t)512 * 1024;
        g.gcnt = gcnt; g.C = (bf16*)(ws + WS_YB); g.ldc = D;
        hipLaunchKernelGGL(k_ngemm<0>, dim3(2048), dim3(256), 0, stream, g); }
}
static bool phase_is_naive(int k) {
    if (k < 1 || k > 36) return false;
    const int L = (k - 1) / 9, sub = (k - 1) % 9;
    if (sub == 3) return (MK_NAIVE_ATTN >> L) & 1;
    if (sub == 1) return MK_NAIVE_GEMM & 1;
    if (sub == 4) return (MK_NAIVE_GEMM >> 1) & 1;
    if (sub == 7) return (MK_NAIVE_GEMM >> 2) & 1;
    if (sub == 8) return (MK_NAIVE_GEMM >> 3) & 1;
    return false;
}
extern "C" void kernel_launch(void* const* d_in, const int* in_sizes, int n_in, void* d_out, int out_size, void* d_ws, size_t ws_size, hipStream_t stream) {
    static int grid = 0;
    if (grid == 0) {
        if (n_in != 29 || out_size != SEQ * D || ws_size < WS_END) { fprintf(stderr, "kernel_launch: unexpected shapes n_in %d out %d ws %zu\n", n_in, out_size, ws_size); grid = -1; return; }
        int dev = 0, cus = 0, per_cu = 0;
        if (hipGetDevice(&dev) != hipSuccess || hipDeviceGetAttribute(&cus, hipDeviceAttributeMultiprocessorCount, dev) != hipSuccess) { grid = -1; return; }
        if (hipFuncSetAttribute((const void*)mk_fwd, hipFuncAttributeMaxDynamicSharedMemorySize, LDS_BYTES) != hipSuccess) { fprintf(stderr, "kernel_launch: hipFuncSetAttribute failed\n"); grid = -1; return; }
        if (hipOccupancyMaxActiveBlocksPerMultiprocessor(&per_cu, (const void*)mk_fwd, 512, LDS_BYTES) != hipSuccess || per_cu < 1)
            fprintf(stderr, "kernel_launch: note: occupancy query reports %d blocks per CU\n", per_cu);
        (void)hipGetLastError();
        grid = cus;
    }
    if (grid < 0) return;
    Args a{};
    for (int i = 0; i < 29; ++i) a.p.in[i] = (const float*)d_in[i];
    a.p.out = (float*)d_out; a.p.ws = (unsigned char*)d_ws;
    (void)hipMemsetAsync((char*)d_ws + WS_CTL, 0, CTL_ZERO_BYTES, stream);
    int cur = 0, li = 0;
    auto flush = [&](int lo, int hi) { if (lo >= hi) return; a.ph_lo = lo; a.ph_hi = hi; a.li = li++; hipLaunchKernelGGL(mk_fwd, dim3(grid), dim3(512), LDS_BYTES, stream, a); };
    for (int k = 0; k < NPHASE; ++k) {
        if (phase_is_naive(k)) { flush(cur, k); cur = k + 1; const int L = (k - 1) / 9, sub = (k - 1) % 9;
            if (L == 0) naive_phase<0>(a.p, sub, stream); else if (L == 1) naive_phase<1>(a.p, sub, stream); else if (L == 2) naive_phase<2>(a.p, sub, stream); else naive_phase<3>(a.p, sub, stream); }
        else if (MK_SPLIT_ALL) { flush(cur, k + 1); cur = k + 1; }
    }
    flush(cur, NPHASE);
}
```

```cpp
#include <hip/hip_runtime.h>
#include <cstdio>
#include <cstdint>

typedef unsigned short bf16;
typedef float f32x4 __attribute__((ext_vector_type(4)));
typedef float f32x2 __attribute__((ext_vector_type(2)));
typedef unsigned u32x4 __attribute__((ext_vector_type(4)));
typedef unsigned u32x2 __attribute__((ext_vector_type(2)));

constexpr int D = 1024, SEQ = 16384, CTX = 256, T = SEQ + CTX, DEPTH = 4, HD = 64;
constexpr int NEXP = 32, DEXP = 512;
constexpr float EPS = 1e-6f;
constexpr int XB_ROWS = 41472;

constexpr size_t MiB = 1u << 20;
constexpr size_t WS_CTL = 0, CTL_ZERO_BYTES = 256 * 1024;
constexpr size_t WS_MODV = 1 * MiB;
constexpr size_t WS_ROPE = 1 * MiB + 512 * 1024;
constexpr size_t WS_RTE = 2 * MiB;
constexpr size_t WS_RTP = 2 * MiB + 256 * 1024;
constexpr size_t WS_RTW = 2 * MiB + 512 * 1024;
constexpr size_t WS_LAM = 3 * MiB;
constexpr size_t WS_WRT = 3 * MiB + 65536;
constexpr size_t WS_WQKV = 4 * MiB, WS_WO = 22 * MiB, WS_WG = 32 * MiB, WS_WD = 288 * MiB;
constexpr size_t WS_X = 416 * MiB, WS_H = 481 * MiB, WS_QKV = 514 * MiB, WS_XB = WS_QKV, WS_O = 612 * MiB, WS_HID = 645 * MiB, WS_YB = 686 * MiB, WS_OSCR = 767 * MiB, WS_END = 832 * MiB;
constexpr size_t WS_LIST = WS_OSCR;
constexpr int LCAP = T;
constexpr size_t WS_NSCR = 832 * MiB;
constexpr int CW_CNT = 1024;
constexpr int CW_QKMAX = 2048;
constexpr int CW_BAR = 8192;
constexpr int RING_BYTES = 131072, MISC_OFF = 147456, LDS_BYTES = MISC_OFF + 4096;

struct P { const float* in[29]; float* out; unsigned char* ws; };
enum { I_X = 0, I_C, I_CTX, I_CCTX, I_MODW, I_MODB, I_N1G, I_N2G, I_AQKV, I_AWO, I_ALAM, I_ASUB, I_BQKV, I_BWO, I_BSINK, I_CQKV, I_CWO, I_CQKN, I_DQKV, I_DWO, I_DRPB,
       I_RG, I_RGB, I_RE, I_REB, I_WGATE, I_WUP, I_WDOWN, I_FING };

__device__ __forceinline__ unsigned f2bf(float f) { unsigned u = __builtin_bit_cast(unsigned, f); return (u + 0x7fffu + ((u >> 16) & 1u)) >> 16; }
__device__ __forceinline__ unsigned pk2(float lo, float hi) { typedef float f2_t_ __attribute__((ext_vector_type(2))); typedef __bf16 b2_t_ __attribute__((ext_vector_type(2)));
    f2_t_ v = {lo, hi}; b2_t_ b = __builtin_convertvector(v, b2_t_); return __builtin_bit_cast(unsigned, b); }
__device__ __forceinline__ float bf2f(unsigned short b) { return __builtin_bit_cast(float, (unsigned)b << 16); }
__device__ __forceinline__ float bflo(unsigned w) { return __builtin_bit_cast(float, w << 16); }
__device__ __forceinline__ float bfhi(unsigned w) { return __builtin_bit_cast(float, w & 0xffff0000u); }
__device__ __forceinline__ float wave_sum(float v) {
#pragma unroll
    for (int o = 1; o < 64; o <<= 1) v += __shfl_xor(v, o);
    return v;
}
__device__ __forceinline__ float wave_max(float v) {
#pragma unroll
    for (int o = 1; o < 64; o <<= 1) v = fmaxf(v, __shfl_xor(v, o));
    return v;
}
__device__ __forceinline__ float silu(float x) { return x / (1.f + expf(-x)); }

__device__ __forceinline__ void ph_modvec(const P& p, unsigned char* lds) {
    float (*s_c)[1024] = (float (*)[1024])lds;
    float (*s_red)[2][128] = (float (*)[2][128])(lds + 8192);
    const int tid = threadIdx.x, wave = tid >> 6, lane = tid & 63;
    float* modv = (float*)(p.ws + WS_MODV);
    for (int i = tid; i < 1024; i += 512) { s_c[0][i] = silu(p.in[I_C][i]); s_c[1][i] = silu(p.in[I_CCTX][i]); }
    __syncthreads();
    for (int item = blockIdx.x; item < 192; item += gridDim.x) {
        const int l = item / 48, ch = item % 48;
        const float* W = p.in[I_MODW] + (size_t)l * 1024 * 6144 + ch * 128 + lane * 2;
        float a0 = 0.f, a1 = 0.f, b0 = 0.f, b1 = 0.f;
#pragma unroll 8
        for (int k = wave * 128; k < wave * 128 + 128; ++k) {
            const f32x2 w = *(const f32x2*)(W + (size_t)k * 6144);
            const float sl = s_c[0][k], sc = s_c[1][k];
            a0 += sl * w.x; a1 += sl * w.y; b0 += sc * w.x; b1 += sc * w.y;
        }
        s_red[wave][0][lane * 2] = a0; s_red[wave][0][lane * 2 + 1] = a1; s_red[wave][1][lane * 2] = b0; s_red[wave][1][lane * 2 + 1] = b1;
        __syncthreads();
        if (tid < 256) { const int which = tid >> 7, c = tid & 127; float s = 0.f;
#pragma unroll
            for (int w = 0; w < 8; ++w) s += s_red[w][which][c];
            modv[(size_t)(l * 2 + which) * 6144 + ch * 128 + c] = s + p.in[I_MODB][l * 6144 + ch * 128 + c]; }
        __syncthreads();
    }
    if (blockIdx.x == gridDim.x - 1) {
        float* rope = (float*)(p.ws + WS_ROPE);
        for (int i = tid; i < 256 * 16; i += 512) { const int pos = i >> 4, c = i & 15;
            const float inv = 1.0f / powf(10000.f, (float)c / 16.f); const float ang = (float)pos * inv;
            rope[i * 2] = cosf(ang); rope[i * 2 + 1] = sinf(ang); }
        if (wave == 0) { const float* lv = p.in[I_ALAM];
            const float s1 = wave_sum(lv[lane] * lv[64 + lane]), s2 = wave_sum(lv[128 + lane] * lv[192 + lane]);
            if (lane == 0) ((float*)(p.ws + WS_LAM))[0] = expf(s1) - expf(s2) + 0.2f; }
    }
}

struct RowV { f32x4 v[4]; };
__device__ __forceinline__ RowV ldrow(const float* p, int lane) { RowV r; const f32x4* q = (const f32x4*)p + lane;
#pragma unroll
    for (int j = 0; j < 4; ++j) r.v[j] = q[64 * j]; return r; }
__device__ __forceinline__ void strow(float* p, int lane, const RowV& r) { f32x4* q = (f32x4*)p + lane;
#pragma unroll
    for (int j = 0; j < 4; ++j) q[64 * j] = r.v[j]; }
__device__ __forceinline__ RowV ldrow_bf(const bf16* p, int lane) { RowV r; const u32x2* q = (const u32x2*)p + lane;
#pragma unroll
    for (int j = 0; j < 4; ++j) { const u32x2 w = q[64 * j]; r.v[j] = (f32x4){bflo(w.x), bfhi(w.x), bflo(w.y), bfhi(w.y)}; } return r; }
__device__ __forceinline__ void strow_bf(bf16* p, int lane, const RowV& r) { u32x2* q = (u32x2*)p + lane;
#pragma unroll
    for (int j = 0; j < 4; ++j) { u32x2 w; w.x = pk2(r.v[j].x, r.v[j].y); w.y = pk2(r.v[j].z, r.v[j].w); q[64 * j] = w; } }
__device__ __forceinline__ float row_ss(const RowV& r) { float s = 0.f;
#pragma unroll
    for (int j = 0; j < 4; ++j) s += (r.v[j].x * r.v[j].x + r.v[j].y * r.v[j].y) + (r.v[j].z * r.v[j].z + r.v[j].w * r.v[j].w);
    return wave_sum(s); }

__device__ __forceinline__ void moe_prefix(const int* gcnt, int* ps) {
    if (threadIdx.x < 64) { const int lane = threadIdx.x; int v = lane < 32 ? (gcnt[lane] + 255) / 256 * 256 : 0;
#pragma unroll
        for (int d = 1; d < 32; d <<= 1) { const int t = __shfl_up(v, d); if (lane >= d) v += t; }
        if (lane < 32) ps[lane + 1] = v;
        if (lane == 0) ps[0] = 0; }
    __syncthreads();
}
template <int L> __device__ __forceinline__ void norm1_rows(const P& p, const int* ps, int gw, int ngw, int lane, bool ctxpart) {
    bf16* X = (bf16*)(p.ws + WS_X); bf16* H = (bf16*)(p.ws + WS_H); const bf16* YB = (const bf16*)(p.ws + WS_YB);
    const float* modv = (const float*)(p.ws + WS_MODV);
    const int* rtp = (const int*)(p.ws + WS_RTP); const int* rte = (const int*)(p.ws + WS_RTE); const float* rtw = (const float*)(p.ws + WS_RTW);
    const int which = ctxpart ? 1 : 0;
    RowV g2{}, sh{}, sc{}, ng{};
    if (L > 0) g2 = ldrow(modv + (size_t)((L - 1) * 2 + which) * 6144 + 5120, lane);
    if (L < 4) { sh = ldrow(modv + (size_t)(L * 2 + which) * 6144, lane); sc = ldrow(modv + (size_t)(L * 2 + which) * 6144 + 1024, lane); ng = ldrow(p.in[I_N1G] + L * 1024, lane); }
    else ng = ldrow(p.in[I_FING], lane);
    const int m0 = ctxpart ? 0 : CTX, m1 = ctxpart ? CTX : T;
    for (int m = m0 + gw; m < m1; m += ngw) {
        RowV x;
        if (L == 0) x = ctxpart ? ldrow(p.in[I_CTX] + (size_t)m * D, lane) : ldrow(p.in[I_X] + (size_t)(m - CTX) * D, lane);
        else {
            x = ldrow_bf(X + (size_t)m * D, lane);
            const int p0 = ps[rte[m * 2]] + rtp[m * 2], p1 = ps[rte[m * 2 + 1]] + rtp[m * 2 + 1]; const float w0 = rtw[m * 2], w1 = rtw[m * 2 + 1];
            const RowV y0 = ldrow_bf(YB + (size_t)p0 * D, lane), y1 = ldrow_bf(YB + (size_t)p1 * D, lane);
#pragma unroll
            for (int j = 0; j < 4; ++j) x.v[j] += g2.v[j] * (y0.v[j] * w0 + y1.v[j] * w1);
        }
        if (L < 4) strow_bf(X + (size_t)m * D, lane, x);
        const float r = 1.0f / sqrtf(row_ss(x) * (1.f / D) + EPS);
        RowV h;
        if (L < 4) {
#pragma unroll
            for (int j = 0; j < 4; ++j) h.v[j] = (x.v[j] * r) * ng.v[j] * (1.f + sc.v[j]) + sh.v[j];
            strow_bf(H + (size_t)m * D, lane, h);
        } else {
#pragma unroll
            for (int j = 0; j < 4; ++j) h.v[j] = (x.v[j] * r) * ng.v[j];
            strow(p.out + (size_t)(m - CTX) * D, lane, h);
        }
    }
}
template <int L> __device__ __forceinline__ void ph_norm1(const P& p, unsigned char* lds) {
    const int lane = threadIdx.x & 63, gw = blockIdx.x * 8 + (threadIdx.x >> 6), ngw = gridDim.x * 8;
    int* ps = (int*)(lds + MISC_OFF + 64);
    if (L > 0) { __syncthreads(); moe_prefix((const int*)(p.ws + WS_CTL) + CW_CNT + (L - 1) * 32, ps); }
    if (L < 4) { const int cw = ((int)blockIdx.x < CTX && (int)(threadIdx.x >> 6) == ((int)blockIdx.x & 7)) ? (int)blockIdx.x : CTX;
        if (cw < CTX) norm1_rows<L>(p, ps, cw, CTX, lane, true); }
    norm1_rows<L>(p, ps, gw, ngw, lane, false);
}

__device__ __forceinline__ float dpp_row_sum(float v) {
    v += __int_as_float(__builtin_amdgcn_update_dpp(0, __float_as_int(v), 0xB1, 0xf, 0xf, true));
    v += __int_as_float(__builtin_amdgcn_update_dpp(0, __float_as_int(v), 0x4E, 0xf, 0xf, true));
    v += __int_as_float(__builtin_amdgcn_update_dpp(0, __float_as_int(v), 0x141, 0xf, 0xf, true));
    v += __int_as_float(__builtin_amdgcn_update_dpp(0, __float_as_int(v), 0x140, 0xf, 0xf, true));
    return v;
}
__device__ __forceinline__ float reduce4(float a, float b, float c, float d, int lane) {
    a = dpp_row_sum(a); b = dpp_row_sum(b); c = dpp_row_sum(c); d = dpp_row_sum(d);
    const bool odd = (lane >> 4) & 1;
    const float ab = (odd ? b : a) + __shfl_xor(odd ? a : b, 16);
    const float cd = (odd ? d : c) + __shfl_xor(odd ? c : d, 16);
    auto rr = __builtin_amdgcn_permlane32_swap(__float_as_uint(ab), __float_as_uint(cd), false, false);
    return __uint_as_float(rr[0]) + __uint_as_float(rr[1]);
}
__device__ __forceinline__ void route_row(const float* lg_, int m, int* cnt_l, int* rte, float* rtw, bool active_, int& ea_o, int& eb_o, int& ra_o, int& rb_o) {
    float lg[4];
#pragma unroll
    for (int n = 0; n < 4; ++n) lg[n] = lg_[n];
    int g = 0; float gm = lg[0];
#pragma unroll
    for (int n = 1; n < 4; ++n) if (lg[n] > gm) { gm = lg[n]; g = n; }
    float gs = 0.f;
#pragma unroll
    for (int n = 0; n < 4; ++n) gs += expf(lg[n] - gm);
    const float gate_g = 1.0f / gs;
    float le[8];
#pragma unroll
    for (int i = 0; i < 8; ++i) le[i] = lg_[4 + g * 8 + i];
    int i0 = 0; float v0 = le[0];
#pragma unroll
    for (int i = 1; i < 8; ++i) if (le[i] > v0) { v0 = le[i]; i0 = i; }
    int i1 = -1; float v1 = -INFINITY;
#pragma unroll
    for (int i = 0; i < 8; ++i) if (i != i0 && le[i] > v1) { v1 = le[i]; i1 = i; }
    const float e1 = expf(v1 - v0); const float w0 = gate_g / (1.f + e1), w1 = gate_g * e1 / (1.f + e1);
    ea_o = g * 8 + i0; eb_o = g * 8 + i1; ra_o = 0; rb_o = 0;
    if (active_) { ra_o = atomicAdd(&cnt_l[ea_o], 1); rb_o = atomicAdd(&cnt_l[eb_o], 1);
        rte[m * 2] = ea_o; rte[m * 2 + 1] = eb_o; rtw[m * 2] = w0; rtw[m * 2 + 1] = w1; }
}
typedef short n2_bf16x8 __attribute__((ext_vector_type(8)));
__device__ __forceinline__ void split_hl(float x, unsigned& h, unsigned& l) { h = f2bf(x); l = f2bf(x - __builtin_bit_cast(float, h << 16)); }
__device__ __forceinline__ void split_hl2(float x0, float x1, unsigned& hw, unsigned& lw) { hw = pk2(x0, x1);
    lw = pk2(x0 - __builtin_bit_cast(float, hw << 16), x1 - __builtin_bit_cast(float, hw & 0xffff0000u)); }
template <int L> __device__ __forceinline__ int n2_row(int b, int slot) {
    if (b < 0) return (L < 3 && slot == 0 && (int)blockIdx.x < CTX) ? (int)blockIdx.x : -1;
    const int m = CTX + (int)blockIdx.x + (int)gridDim.x * (16 * b + slot); return m < T ? m : -1;
}
template <int L> __device__ __forceinline__ void ph_norm2(const P& p, unsigned char* lds) {
    constexpr int A_HI = 0, A_LO = 32768, PART = 65536, LGS = PART + 8 * 16 * 48 * 4;
    constexpr int CI_HI = 94208, CI_LO = 96256, CPART = 98304, LGA = 102400;
    const bool has_c = L < 3 && (int)blockIdx.x < CTX;
    int* cnt_l = (int*)(lds + MISC_OFF + 256); int* base_l = cnt_l + 32;
    const int tid = threadIdx.x, lane = tid & 63, wave = __builtin_amdgcn_readfirstlane(tid >> 6);
    const bf16* X = (const bf16*)(p.ws + WS_X); bf16* H = (bf16*)(p.ws + WS_H);
    const float* modv = (const float*)(p.ws + WS_MODV);
    int* rte = (int*)(p.ws + WS_RTE); int* rtp = (int*)(p.ws + WS_RTP); float* rtw = (float*)(p.ws + WS_RTW);
    int* gcnt = (int*)(p.ws + WS_CTL) + CW_CNT + L * 32; int* list = (int*)(p.ws + WS_LIST);
    float* bias_l = (float*)(lds + MISC_OFF + 1024);
    if (tid < 36) bias_l[tid] = tid < 4 ? p.in[I_RGB][L * 4 + tid] : p.in[I_REB][L * 32 + tid - 4];
    if (tid < 32) cnt_l[tid] = 0;
    n2_bf16x8 Bh[3][4], Bl[3][4];
    { const float* wrt = (const float*)(p.ws + WS_WRT) + (size_t)L * 36 * 1024;
#pragma unroll
      for (int nt = 0; nt < 3; ++nt)
#pragma unroll
          for (int ks = 0; ks < 4; ++ks) { const int n = 16 * nt + (lane & 15), k0 = 128 * wave + 32 * ks + 8 * (lane >> 4);
              f32x4 a = {0.f, 0.f, 0.f, 0.f}, b = {0.f, 0.f, 0.f, 0.f};
              if (n < 36) { a = *(const f32x4*)(wrt + n * 1024 + k0); b = *(const f32x4*)(wrt + n * 1024 + k0 + 4); }
              unsigned h_[4], l_[4];
              split_hl2(a.x, a.y, h_[0], l_[0]); split_hl2(a.z, a.w, h_[1], l_[1]); split_hl2(b.x, b.y, h_[2], l_[2]); split_hl2(b.z, b.w, h_[3], l_[3]);
              u32x4 hw = {h_[0], h_[1], h_[2], h_[3]}, lw = {l_[0], l_[1], l_[2], l_[3]};
              Bh[nt][ks] = *reinterpret_cast<n2_bf16x8*>(&hw); Bl[nt][ks] = *reinterpret_cast<n2_bf16x8*>(&lw); } }
    __syncthreads();
    const int nbatch = (SEQ / (int)gridDim.x + 15) / 16 + 1;
    const RowV ng = ldrow(p.in[I_N2G] + L * 1024, lane), sh = ldrow(modv + (size_t)(L * 2) * 6144 + 3072, lane), sc = ldrow(modv + (size_t)(L * 2) * 6144 + 4096, lane);
    for (int b = 0; b < nbatch; ++b) {
        if (n2_row<L>(b, 0) < 0) break;
        const bool cpass = has_c && b == 0;
        {
#pragma unroll
          for (int s_ = 0; s_ < 2; ++s_) { const int slot = 2 * wave + s_, m = n2_row<L>(b, slot);
              if (m >= 0) { const RowV x = ldrow_bf(X + (size_t)m * D, lane);
                  const float rs = 1.0f / sqrtf(row_ss(x) * (1.f / D) + EPS);
                  RowV h;
#pragma unroll
                  for (int j = 0; j < 4; ++j) h.v[j] = (x.v[j] * rs) * ng.v[j] * (1.f + sc.v[j]) + sh.v[j];
                  strow_bf(H + (size_t)m * D, lane, h);
#pragma unroll
                  for (int j = 0; j < 4; ++j) { unsigned hw0, lw0, hw1, lw1;
                      split_hl2(h.v[j].x, h.v[j].y, hw0, lw0); split_hl2(h.v[j].z, h.v[j].w, hw1, lw1);
                      const int off = slot * 2048 + ((((lane >> 1) + 32 * j) ^ slot) << 4) + 8 * (lane & 1);
                      *(u32x2*)(lds + A_HI + off) = (u32x2){hw0, hw1}; *(u32x2*)(lds + A_LO + off) = (u32x2){lw0, lw1}; } } }
          if (cpass && wave == 7) { const int m = (int)blockIdx.x;
              const RowV sh1 = ldrow(modv + (size_t)(L * 2 + 1) * 6144 + 3072, lane), sc1 = ldrow(modv + (size_t)(L * 2 + 1) * 6144 + 4096, lane);
              const RowV x = ldrow_bf(X + (size_t)m * D, lane);
              const float rs = 1.0f / sqrtf(row_ss(x) * (1.f / D) + EPS);
              RowV h;
#pragma unroll
              for (int j = 0; j < 4; ++j) h.v[j] = (x.v[j] * rs) * ng.v[j] * (1.f + sc1.v[j]) + sh1.v[j];
              strow_bf(H + (size_t)m * D, lane, h);
#pragma unroll
              for (int j = 0; j < 4; ++j) { unsigned hw0, lw0, hw1, lw1;
                  split_hl2(h.v[j].x, h.v[j].y, hw0, lw0); split_hl2(h.v[j].z, h.v[j].w, hw1, lw1);
                  const int off = (((lane >> 1) + 32 * j) << 4) + 8 * (lane & 1);
                  *(u32x2*)(lds + CI_HI + off) = (u32x2){hw0, hw1}; *(u32x2*)(lds + CI_LO + off) = (u32x2){lw0, lw1}; } } }
        __syncthreads();
        { f32x4 acc[3] = {{0.f, 0.f, 0.f, 0.f}, {0.f, 0.f, 0.f, 0.f}, {0.f, 0.f, 0.f, 0.f}};
          const int arow = lane & 15;
#pragma unroll
          for (int ks = 0; ks < 4; ++ks) { const int off = arow * 2048 + (((16 * wave + 4 * ks + (lane >> 4)) ^ arow) << 4);
              const n2_bf16x8 ah = *(const n2_bf16x8*)(lds + A_HI + off), al = *(const n2_bf16x8*)(lds + A_LO + off);
#pragma unroll
              for (int nt = 0; nt < 3; ++nt) { acc[nt] = __builtin_amdgcn_mfma_f32_16x16x32_bf16(ah, Bh[nt][ks], acc[nt], 0, 0, 0);
                  acc[nt] = __builtin_amdgcn_mfma_f32_16x16x32_bf16(al, Bh[nt][ks], acc[nt], 0, 0, 0); acc[nt] = __builtin_amdgcn_mfma_f32_16x16x32_bf16(ah, Bl[nt][ks], acc[nt], 0, 0, 0); } }
          float* part = (float*)(lds + PART) + wave * 16 * 48;
#pragma unroll
          for (int nt = 0; nt < 3; ++nt)
#pragma unroll
              for (int i = 0; i < 4; ++i) part[(4 * (lane >> 4) + i) * 48 + 16 * nt + (lane & 15)] = acc[nt][i]; }
        if (cpass) { f32x4 acc[3] = {{0.f, 0.f, 0.f, 0.f}, {0.f, 0.f, 0.f, 0.f}, {0.f, 0.f, 0.f, 0.f}};
#pragma unroll
          for (int ks = 0; ks < 4; ++ks) { const int off = (16 * wave + 4 * ks + (lane >> 4)) << 4;
              const n2_bf16x8 ah = *(const n2_bf16x8*)(lds + CI_HI + off), al = *(const n2_bf16x8*)(lds + CI_LO + off);
#pragma unroll
              for (int nt = 0; nt < 3; ++nt) { acc[nt] = __builtin_amdgcn_mfma_f32_16x16x32_bf16(ah, Bh[nt][ks], acc[nt], 0, 0, 0);
                  acc[nt] = __builtin_amdgcn_mfma_f32_16x16x32_bf16(al, Bh[nt][ks], acc[nt], 0, 0, 0); acc[nt] = __builtin_amdgcn_mfma_f32_16x16x32_bf16(ah, Bl[nt][ks], acc[nt], 0, 0, 0); } }
          float* cpart = (float*)(lds + CPART) + wave * 48;
          if (lane < 16) {
#pragma unroll
              for (int nt = 0; nt < 3; ++nt) cpart[16 * nt + lane] = acc[nt][0]; } }
        __syncthreads();
#pragma unroll
        for (int s_ = 0; s_ < 2; ++s_) { const int slot = 2 * wave + s_, m = n2_row<L>(b, slot);
            if (m >= 0 && lane < 36) { float v = bias_l[lane];
#pragma unroll
                for (int w = 0; w < 8; ++w) v += ((const float*)(lds + PART))[(w * 16 + slot) * 48 + lane];
                ((float*)(lds + LGA))[(16 * b + slot) * 40 + lane] = v; } }
        if (cpass && wave == 7 && lane < 36) { float v = bias_l[lane];
#pragma unroll
            for (int w = 0; w < 8; ++w) v += ((const float*)(lds + CPART))[w * 48 + lane];
            ((float*)(lds + LGA))[(16 * nbatch) * 40 + lane] = v; }
    }
    __syncthreads();
    int r_m = -1, r_ea = 0, r_eb = 0, r_ra = 0, r_rb = 0;
    if (wave < 2) { const int j = tid;
        if (j < 16 * nbatch) r_m = n2_row<L>(j >> 4, j & 15); else if (j == 16 * nbatch && has_c) r_m = (int)blockIdx.x;
        const int jj = j <= 16 * nbatch ? j : 0;
        route_row((const float*)(lds + LGA) + jj * 40, r_m, cnt_l, rte, rtw, r_m >= 0, r_ea, r_eb, r_ra, r_rb); }
    __syncthreads();
    if (tid < 32) base_l[tid] = atomicAdd(&gcnt[tid], cnt_l[tid]);
    __syncthreads();
    if (r_m >= 0) { const int pa = r_ra + base_l[r_ea], pb = r_rb + base_l[r_eb];
        rtp[r_m * 2] = pa; rtp[r_m * 2 + 1] = pb; list[(size_t)r_ea * LCAP + pa] = r_m; list[(size_t)r_eb * LCAP + pb] = r_m; }
}

template <int L> __device__ __forceinline__ void ph_gather(const P& p, unsigned char* lds) {
    int* ps = (int*)(lds + MISC_OFF + 64);
    const int tid = threadIdx.x, lane = tid & 63, gw = blockIdx.x * 8 + (tid >> 6), ngw = gridDim.x * 8;
    moe_prefix((const int*)(p.ws + WS_CTL) + CW_CNT + L * 32, ps);
    const bf16* H = (const bf16*)(p.ws + WS_H); bf16* XB = (bf16*)(p.ws + WS_XB);
    const int* rte = (const int*)(p.ws + WS_RTE); int* rtp = (int*)(p.ws + WS_RTP);
    for (int m = (L == 3 ? CTX : 0) + gw; m < T; m += ngw) {
        const int d0 = ps[rte[m * 2]] + rtp[m * 2], d1 = ps[rte[m * 2 + 1]] + rtp[m * 2 + 1];
        const u32x4* src = (const u32x4*)(H + (size_t)m * D) + lane; const u32x4 a = src[0], b = src[64];
        u32x4* o0 = (u32x4*)(XB + (size_t)d0 * D) + lane; u32x4* o1 = (u32x4*)(XB + (size_t)d1 * D) + lane;
        o0[0] = a; o0[64] = b; o1[0] = a; o1[64] = b;
        if (lane == 0) { rtp[m * 2] = d0; rtp[m * 2 + 1] = d1; }
    }
}

template <int L> __device__ __forceinline__ void ph_rope(const P& p, unsigned char* lds) {
    constexpr int LD = (L == 0) ? 3072 : 1536, NHQK = (L == 0) ? 32 : 20;
    const int tid = threadIdx.x, lane = tid & 63, gw = blockIdx.x * 8 + (tid >> 6), ngw = gridDim.x * 8;
    bf16* QKV = (bf16*)(p.ws + WS_QKV); const float* rope = (const float*)(p.ws + WS_ROPE);
    unsigned* lmax = (unsigned*)(lds + MISC_OFF + 2560);
    float hmx[2] = {0.f, 0.f};
    if (L == 0) { if (tid < 32) lmax[tid] = 0u; __syncthreads(); }
    for (int m = (int)blockIdx.x + (int)gridDim.x * (tid >> 6); m < T; m += ngw) {
        const bool lat = m >= CTX; const int t = m - CTX, pr = t >> 6, pc = t & 63;
#pragma unroll
        for (int u0 = 0; u0 < NHQK * 4; u0 += 64) {
            const int u = u0 + lane; const bool act = u < NHQK * 4;
            const int head = u >> 2, a = (u >> 1) & 1, ch = u & 1;
            bf16* px = QKV + (size_t)m * LD + head * 64 + a * 32 + ch * 8;
            float x1[8], x2[8];
            if (act) { const u32x4 w1 = *(const u32x4*)px, w2 = *(const u32x4*)(px + 16);
#pragma unroll
                for (int i = 0; i < 4; ++i) { x1[2 * i] = bflo(w1[i]); x1[2 * i + 1] = bfhi(w1[i]); x2[2 * i] = bflo(w2[i]); x2[2 * i + 1] = bfhi(w2[i]); } }
            else {
#pragma unroll
                for (int i = 0; i < 8; ++i) { x1[i] = 0.f; x2[i] = 0.f; } }
            if (L == 2) {
                float ss = 0.f;
#pragma unroll
                for (int i = 0; i < 8; ++i) ss += x1[i] * x1[i] + x2[i] * x2[i];
                ss += __shfl_xor(ss, 1); ss += __shfl_xor(ss, 2);
                const float r = 1.0f / sqrtf(ss * (1.f / 64.f) + EPS);
                const float* gq = p.in[I_CQKN] + (head < 16 ? 0 : 64) + a * 32 + ch * 8;
#pragma unroll
                for (int i = 0; i < 8; ++i) { x1[i] = x1[i] * r * gq[i]; x2[i] = x2[i] * r * gq[16 + i]; }
            }
            if (lat && L != 0) { const int pos = a == 0 ? pr : pc;
#pragma unroll
                for (int i = 0; i < 8; ++i) { const f32x2 cs = *(const f32x2*)(rope + (size_t)(pos * 16 + ch * 8 + i) * 2);
                    const float y1 = x1[i] * cs.x - x2[i] * cs.y, y2 = x2[i] * cs.x + x1[i] * cs.y; x1[i] = y1; x2[i] = y2; } }
            if (L == 0) {
                float ss = 0.f;
#pragma unroll
                for (int i = 0; i < 8; ++i) ss += x1[i] * x1[i] + x2[i] * x2[i];
                ss += __shfl_xor(ss, 1); ss += __shfl_xor(ss, 2);
                hmx[u0 >> 6] = fmaxf(hmx[u0 >> 6], ss);
            }
            if (L >= 1 && head < 16) {
#pragma unroll
                for (int i = 0; i < 8; ++i) { x1[i] *= 0.125f * 1.4426950408889634f; x2[i] *= 0.125f * 1.4426950408889634f; } }
            if (act && L >= 1) { u32x4 w1, w2;
#pragma unroll
                for (int i = 0; i < 4; ++i) { w1[i] = pk2(x1[2 * i], x1[2 * i + 1]); w2[i] = pk2(x2[2 * i], x2[2 * i + 1]); }
                *(u32x4*)px = w1; *(u32x4*)(px + 16) = w2; }
        }
    }
    if (L == 0) {
        if ((lane & 3) == 0) { atomicMax(&lmax[lane >> 2], __float_as_uint(hmx[0])); atomicMax(&lmax[16 + (lane >> 2)], __float_as_uint(hmx[1])); }
        __syncthreads();
        if (tid < 32) atomicMax((unsigned*)(p.ws + WS_CTL) + CW_QKMAX + tid, lmax[tid]);
    }
}

struct NG { const bf16* A; int lda; const float* W; const float* W2; int N, K; size_t wstride; const int* gcnt; int mtiles;
            bf16* C; int ldc; float* X; const float* gate_lat; const float* gate_ctx; int row_off; int pad; };
template <int EPI> __global__ void __launch_bounds__(256) k_ngemm(NG g) {
    __shared__ float As[16][68]; __shared__ float Bs[16][64]; __shared__ float Bs2[16][64]; __shared__ int ps[33];
    const int tid = threadIdx.x, tx = tid & 15, ty = tid >> 4;
    int total_mt = g.mtiles;
    if (g.gcnt) { moe_prefix(g.gcnt, ps); total_mt = ps[32] / 64; }
    const int ntn = g.N / 64;
    for (int tile = blockIdx.x; tile < total_mt * ntn; tile += gridDim.x) {
        const int mt = tile / ntn, nt = tile % ntn;
        const float* W = g.W; const float* W2 = g.W2;
        if (g.gcnt) { int e = 0; while (e < 31 && ps[e + 1] <= mt * 64) ++e; W += (size_t)e * g.wstride; if (EPI == 2) W2 += (size_t)e * g.wstride; }
        float acc[4][4] = {}, acc2[4][4] = {};
        for (int k0 = 0; k0 < g.K; k0 += 16) {
            { const int r = tid >> 2, kc = (tid & 3) * 4; const u32x2 w = *(const u32x2*)(g.A + (size_t)(g.row_off + mt * 64 + r) * g.lda + k0 + kc);
              As[kc][r] = bflo(w.x); As[kc + 1][r] = bfhi(w.x); As[kc + 2][r] = bflo(w.y); As[kc + 3][r] = bfhi(w.y); }
            { const int k = tid >> 4, c = (tid & 15) * 4; *(f32x4*)&Bs[k][c] = *(const f32x4*)(W + (size_t)(k0 + k) * g.N + nt * 64 + c);
              if (EPI == 2) *(f32x4*)&Bs2[k][c] = *(const f32x4*)(W2 + (size_t)(k0 + k) * g.N + nt * 64 + c); }
            __syncthreads();
#pragma unroll
            for (int k = 0; k < 16; ++k) { const f32x4 a = *(const f32x4*)&As[k][ty * 4]; const f32x4 b = *(const f32x4*)&Bs[k][tx * 4];
                f32x4 b2 = {}; if (EPI == 2) b2 = *(const f32x4*)&Bs2[k][tx * 4];
#pragma unroll
                for (int i = 0; i < 4; ++i)
#pragma unroll
                    for (int j = 0; j < 4; ++j) { acc[i][j] += a[i] * b[j]; if (EPI == 2) acc2[i][j] += a[i] * b2[j]; } }
            __syncthreads();
        }
#pragma unroll
        for (int i = 0; i < 4; ++i) { const int row = g.row_off + mt * 64 + ty * 4 + i, col = nt * 64 + tx * 4;
            if (EPI == 0) { u32x2 w; w.x = pk2(acc[i][0], acc[i][1]); w.y = pk2(acc[i][2], acc[i][3]); *(u32x2*)(g.C + (size_t)row * g.ldc + col) = w; }
            else if (EPI == 1) { const float* gt = row < CTX ? g.gate_ctx : g.gate_lat; f32x4* xp = (f32x4*)(g.X + (size_t)row * D + col); f32x4 x = *xp;
#pragma unroll
                for (int j = 0; j < 4; ++j) x[j] += gt[col + j] * acc[i][j];
                *xp = x; }
            else { float h[4];
#pragma unroll
                for (int j = 0; j < 4; ++j) h[j] = silu(acc[i][j]) * acc2[i][j];
                u32x2 w; w.x = pk2(h[0], h[1]); w.y = pk2(h[2], h[3]); *(u32x2*)(g.C + (size_t)row * g.ldc + col) = w; }
        }
    }
}

template <int MODE> __global__ void __launch_bounds__(512) k_nattn(P p) {
    constexpr int LD = (MODE == 0 || MODE == 3) ? 3072 : 1536, NH = MODE == 0 ? 8 : 16, DV = MODE == 0 ? 128 : 64, NSUB = MODE == 0 ? 2 : 1;
    const int tid = threadIdx.x, lane = tid & 63, gw = blockIdx.x * 8 + (tid >> 6), ngw = gridDim.x * 8;
    const bf16* QKV = (const bf16*)(p.ws + WS_QKV); bf16* O = (bf16*)(p.ws + WS_O);
    float* scr = (float*)(p.ws + WS_NSCR) + (size_t)gw * 2 * T;
    const int row0 = MODE == 3 ? CTX : 0;
    const float lam = MODE == 0 ? ((const float*)(p.ws + WS_LAM))[0] : 0.f;
    for (int pair = gw; pair < (T - row0) * NH; pair += ngw) {
        const int m = row0 + pair / NH, h = pair % NH;
        const bool lat = m >= CTX; const int t = m - CTX;
        int ncand = CTX; int r0 = 0, c0 = 0, qr = 0, qc = 0;
        if (lat) { if (MODE == 0 || MODE == 2) ncand = T; else if (MODE == 1) ncand = CTX + 257; else { ncand = CTX + 128; qr = t >> 6; qc = t & 63; r0 = min(max(qr - 4, 0), 248); c0 = min(max(qc - 8, 0), 48); } }
        float outv[2][2]; float Ls[2];
#pragma unroll
        for (int sub = 0; sub < NSUB; ++sub) {
            const int qoff = MODE == 0 ? (2 * h + sub) * 64 : h * 64;
            const int koff = MODE == 0 ? 1024 + (2 * h + sub) * 64 : MODE == 3 ? 1024 + h * 64 : 1024 + (h >> 2) * 64;
            const int voff = MODE == 0 ? 2048 + h * 128 : MODE == 3 ? 2048 + h * 64 : 1280 + (h >> 2) * 64;
            float q[64];
            { const u32x4* qp = (const u32x4*)(QKV + (size_t)m * LD + qoff);
#pragma unroll
              for (int i = 0; i < 8; ++i) { const u32x4 w = qp[i];
#pragma unroll
                  for (int j = 0; j < 4; ++j) { q[i * 8 + 2 * j] = bflo(w[j]); q[i * 8 + 2 * j + 1] = bfhi(w[j]); } } }
            float* sc = scr + sub * T;
            float mx = -INFINITY;
            for (int j = lane; j < ncand; j += 64) {
                int krow = j; float bias = 0.f; bool valid = true;
                if (j >= CTX && lat) {
                    if (MODE == 1) { const int kp = t - 128 + (j - CTX); valid = kp >= 0 && kp < SEQ; krow = CTX + kp; }
                    if (MODE == 3) { const int jj = j - CTX, kr = r0 + (jj >> 4), kc = c0 + (jj & 15); krow = CTX + kr * 64 + kc;
                        bias = p.in[I_DRPB][(h * 15 + (kr - qr + 7)) * 31 + (kc - qc + 15)]; }
                }
                float s = -INFINITY;
                if (valid) { const u32x4* kp = (const u32x4*)(QKV + (size_t)krow * LD + koff); float a = 0.f;
#pragma unroll
                    for (int i = 0; i < 8; ++i) { const u32x4 w = kp[i];
#pragma unroll
                        for (int jq = 0; jq < 4; ++jq) a += q[i * 8 + 2 * jq] * bflo(w[jq]) + q[i * 8 + 2 * jq + 1] * bfhi(w[jq]); }
                    s = a * 0.125f + bias; }
                sc[j] = s; mx = fmaxf(mx, s);
            }
            mx = wave_max(mx);
            float sink = 0.f; if (MODE == 1) { sink = p.in[I_BSINK][h]; mx = fmaxf(mx, sink); }
            float ls = 0.f;
            for (int j = lane; j < ncand; j += 64) { const float e = expf(sc[j] - mx); sc[j] = e; ls += e; }
            ls = wave_sum(ls); if (MODE == 1) ls += expf(sink - mx);
            __threadfence_block();
            float o0 = 0.f, o1 = 0.f;
            for (int j = 0; j < ncand; ++j) {
                int krow = j;
                if (j >= CTX && lat) {
                    if (MODE == 1) { int kp = t - 128 + (j - CTX); kp = min(max(kp, 0), SEQ - 1); krow = CTX + kp; }
                    if (MODE == 3) { const int jj = j - CTX; krow = CTX + (r0 + (jj >> 4)) * 64 + c0 + (jj & 15); }
                }
                const float pj = sc[j]; const bf16* vp = QKV + (size_t)krow * LD + voff;
                o0 += pj * bf2f(vp[lane]); if (DV == 128) o1 += pj * bf2f(vp[64 + lane]);
            }
            outv[sub][0] = o0; outv[sub][1] = o1; Ls[sub] = ls;
            __threadfence_block();
        }
        if (MODE == 0) {
            const float a0 = outv[0][0] / Ls[0] - lam * outv[1][0] / Ls[1], a1 = outv[0][1] / Ls[0] - lam * outv[1][1] / Ls[1];
            const float ss = wave_sum(a0 * a0 + a1 * a1); const float r = 1.0f / sqrtf(ss * (1.f / 128.f) + EPS);
            const float* sg = p.in[I_ASUB];
            O[(size_t)m * D + h * 128 + lane] = (bf16)f2bf(a0 * r * sg[lane] * 0.8f); O[(size_t)m * D + h * 128 + 64 + lane] = (bf16)f2bf(a1 * r * sg[64 + lane] * 0.8f);
        } else O[(size_t)m * D + h * 64 + lane] = (bf16)f2bf(outv[0][0] / Ls[0]);
    }
}


namespace pg8 {
#define PG8_LAS __attribute__((address_space(3)))
typedef unsigned short bf16_t;
typedef short bf16x8 __attribute__((ext_vector_type(8)));
typedef float f32x4 __attribute__((ext_vector_type(4)));
typedef unsigned u32x4 __attribute__((ext_vector_type(4)));
constexpr int BM = 256, BK = 64, HALF = 128, HTB = HALF * BK * 2  , STAGE_BYTES = 8 * HTB, NXCD = 8, WGM = 8;

__host__ __device__ __forceinline__ int lds_byte(int r, int c) { const int st = (r >> 4) * 2 + (c >> 5), rr = r & 15, cc = c & 31, ob = rr * 64 + cc * 2; return st * 1024 + (ob ^ (((ob >> 9) & 1) << 5)); }
__host__ __device__ __forceinline__ void stage_rc(int b, int& R, int& C) { const int st = b / 1024, sb = b % 1024, swz = sb ^ (((sb >> 9) & 1) << 5); R = (st >> 1) * 16 + swz / 64; C = (st & 1) * 32 + (swz % 64) / 2; }
__host__ __device__ __forceinline__ int perm32(int rho) { const int n = rho >> 4, i = rho & 15; return 8 * (i >> 2) + 4 * n + (i & 3); }

struct Unit { int pm, pn, pb; };
struct Gemm { const bf16_t* A; const bf16_t* Bt; int M, N, K; };

struct StaticOrder {
    int nM, nN, nwg, G, c;
    __host__ __device__ void init(int M, int N, int G_, int c_) { nM = M / BM; nN = N / BM; nwg = nM * nN; G = G_; c = c_; }
    __host__ __device__ bool next(int i, Unit& u) const {
        const long L = (long)i * G + c; if (L >= nwg) return false;
        int wgid = (int)L; { const int q = nwg / NXCD, r = nwg % NXCD, xcd = wgid % NXCD, off = wgid / NXCD; wgid = (xcd < r ? xcd * (q + 1) : r * (q + 1) + (xcd - r) * q) + off; }
        const int nig = WGM * nN, gid = wgid / nig, fm = gid * WGM, gsz = (nM - fm) < WGM ? (nM - fm) : WGM;
        u.pm = fm + ((wgid % nig) % gsz); u.pn = (wgid % nig) / gsz; u.pb = u.pn; return true;
    }
    static constexpr bool GATHER = false;
    __device__ __forceinline__ void load_rows(const Unit&, const int (&)[2], const int (&)[2], int, unsigned (&)[2][2]) const {}
    __device__ __forceinline__ void a_ready(const Unit&) const {}
    __device__ __forceinline__ void done(const Unit&) const {}
};

__device__ __forceinline__ unsigned cvt_pk_bf16(float lo, float hi) { unsigned r; asm volatile("v_cvt_pk_bf16_f32 %0, %1, %2" : "=v"(r) : "v"(lo), "v"(hi)); return r; }

template <class Epi, class Sched, bool ALIGN_EPI = false, bool SP2 = false>
__device__ __forceinline__ void gemm_phase(PG8_LAS unsigned char* lds, const Gemm g, const Sched& S, const Epi& E) {
    const int tid = threadIdx.x, wid = __builtin_amdgcn_readfirstlane(tid >> 6), lane = tid & 63, wr = wid >> 2, wc = wid & 3, fr = lane & 15, fq = lane >> 4;
    const int K = g.K, nt = K / BK;
    unsigned voffA[2], voffB[2]; int Rr[2], Cc[2];
#pragma unroll
    for (int i = 0; i < 2; ++i) { int R, C; stage_rc(tid * 16 + i * 8192, R, C); const int Rb = Epi::PERM ? ((R & ~31) + perm32(R & 31)) : R; Rr[i] = R; Cc[i] = C;
        voffA[i] = (unsigned)(R * K + C) * 2u; voffB[i] = (unsigned)(Rb * K + C) * 2u; }
    constexpr bool GATHER = Sched::GATHER;
    unsigned vGc[2][2] = {}, vGn[2][2] = {};
    const size_t kstep = (size_t)(BK * 2);
    const size_t hstep = (size_t)HALF * K * 2;
    const size_t tstep = 2 * hstep;
    const size_t hstepA = GATHER ? 0 : hstep, tstepA = GATHER ? 0 : tstep;
    const unsigned ldsw = (unsigned)wid * 1024u;
    const int aoff = lds_byte(wr * 64 + fr, fq * 8), boff = lds_byte(wc * 32 + fr, fq * 8);
#define PG8_SA(b, h) (((b) * 2 + (h)) * HTB)
#define PG8_SB(b, h) ((4 + (b) * 2 + (h)) * HTB)
#define PG8_STAGE(bufoff, gbase, voff) do { _Pragma("unroll") for (int _i = 0; _i < 2; ++_i) \
        __builtin_amdgcn_global_load_lds((const unsigned*)((const char*)(gbase) + (voff)[_i]), (PG8_LAS unsigned*)(lds + (bufoff) + ldsw + _i * 8192), 16, 0, 0); } while (0)
#define PG8_STAGE_A(bufoff, gbase, h, sel) do { if constexpr (GATHER) { const bool s_ = (sel); unsigned vs_[2] = {s_ ? vGn[h][0] : vGc[h][0], s_ ? vGn[h][1] : vGc[h][1]}; PG8_STAGE(bufoff, gbase, vs_); } else PG8_STAGE(bufoff, gbase, voffA); } while (0)
#define PG8_LDA(dst, b, h) do { _Pragma("unroll") for (int m = 0; m < 4; ++m) _Pragma("unroll") for (int k = 0; k < 2; ++k) dst[m][k] = *(const PG8_LAS bf16x8*)(lds + PG8_SA(b, h) + aoff + m * 2048 + k * 1024); } while (0)
#define PG8_LDB(dst, b, h) do { _Pragma("unroll") for (int n = 0; n < 2; ++n) _Pragma("unroll") for (int k = 0; k < 2; ++k) dst[n][k] = *(const PG8_LAS bf16x8*)(lds + PG8_SB(b, h) + boff + n * 2048 + k * 1024); } while (0)
#define PG8_MMA(ai, bj, At, Bt) do { __builtin_amdgcn_s_setprio(1); _Pragma("unroll") for (int m = 0; m < 4; ++m) _Pragma("unroll") for (int n = 0; n < 2; ++n) _Pragma("unroll") for (int k = 0; k < 2; ++k) \
        acc[ai][bj][m][n] = __builtin_amdgcn_mfma_f32_16x16x32_bf16(Bt[n][k], At[m][k], acc[ai][bj][m][n], 0, 0, 0); __builtin_amdgcn_s_setprio(0); } while (0)
#define PG8_WAIT_V(n) asm volatile("s_waitcnt vmcnt(" #n ")" ::: "memory")
#define PG8_WAIT_L(n) asm volatile("s_waitcnt lgkmcnt(" #n ")" ::: "memory")
#define PG8_BAR __builtin_amdgcn_s_barrier()
#define PG8_SCHED __builtin_amdgcn_sched_barrier(0)
    Unit cur, nxt; int ui = 0;
    if (!S.next(0, cur)) return;
    if constexpr (GATHER) S.load_rows(cur, Rr, Cc, K, vGc);
    f32x4 acc[2][2][4][2];
#pragma unroll
    for (int a = 0; a < 2; ++a)
#pragma unroll
        for (int b = 0; b < 2; ++b)
#pragma unroll
            for (int m = 0; m < 4; ++m)
#pragma unroll
                for (int n = 0; n < 2; ++n) acc[a][b][m][n] = (f32x4){0.f, 0.f, 0.f, 0.f};
    bf16x8 At[4][2], B0[2][2], B1[2][2];
    const char* cA = (const char*)g.A + (size_t)cur.pm * tstepA; const char* cB = (const char*)g.Bt + (size_t)cur.pb * tstep;
    S.a_ready(cur);
    if constexpr (SP2) {
        PG8_STAGE(PG8_SB(0, 0), cB, voffB); PG8_STAGE(PG8_SB(0, 1), cB + hstep, voffB); PG8_STAGE_A(PG8_SA(0, 0), cA, 0, false); PG8_STAGE_A(PG8_SA(0, 1), cA + hstepA, 1, false);
        if (wr == 1) PG8_BAR;
        PG8_WAIT_V(2); PG8_BAR;
        PG8_STAGE(PG8_SB(1, 0), cB + kstep, voffB); PG8_STAGE_A(PG8_SA(1, 0), cA + kstep, 0, false); PG8_STAGE(PG8_SB(1, 1), cB + hstep + kstep, voffB);
        PG8_WAIT_V(6); PG8_BAR;
    } else {
        PG8_STAGE(PG8_SB(0, 0), cB, voffB); PG8_STAGE_A(PG8_SA(0, 0), cA, 0, false); PG8_STAGE(PG8_SB(0, 1), cB + hstep, voffB); PG8_STAGE_A(PG8_SA(0, 1), cA + hstepA, 1, false);
        if (wr == 1) PG8_BAR;
        PG8_WAIT_V(4); PG8_BAR;
        PG8_STAGE(PG8_SB(1, 0), cB + kstep, voffB); PG8_STAGE_A(PG8_SA(1, 0), cA + kstep, 0, false); PG8_STAGE(PG8_SB(1, 1), cB + hstep + kstep, voffB);
        PG8_WAIT_V(6); PG8_BAR;
    }
    for (;;) {
        const bool has_next = S.next(ui + 1, nxt);
        if constexpr (GATHER) { if (has_next) S.load_rows(nxt, Rr, Cc, K, vGn); }
        const char* nA = has_next ? (const char*)g.A + (size_t)nxt.pm * tstepA : cA; const char* nB = has_next ? (const char*)g.Bt + (size_t)nxt.pb * tstep : cB;
        for (int t = 0; t < nt; t += 2) {
            const bool last = (t == nt - 2);
            const char* a1 = cA + (size_t)(t + 1) * kstep;
            const char* a2 = last ? nA : cA + (size_t)(t + 2) * kstep; const char* b2 = last ? nB : cB + (size_t)(t + 2) * kstep;
            const char* a3 = a2 + kstep; const char* b3 = b2 + kstep;
            if (last && has_next) S.a_ready(nxt);
            if constexpr (SP2) {
            PG8_LDB(B0, 0, 0); PG8_LDB(B1, 0, 1); PG8_SCHED; PG8_LDA(At, 0, 0); PG8_STAGE_A(PG8_SA(1, 1), a1 + hstepA, 1, false);
            PG8_WAIT_V(8); PG8_WAIT_L(0); PG8_BAR; PG8_MMA(0, 0, At, B0); PG8_MMA(0, 1, At, B1); PG8_BAR; PG8_SCHED;
            PG8_LDA(At, 0, 1); PG8_STAGE(PG8_SB(0, 0), b2, voffB); PG8_STAGE(PG8_SB(0, 1), b2 + hstep, voffB); PG8_STAGE_A(PG8_SA(0, 0), a2, 0, last && has_next);
            PG8_WAIT_V(8); PG8_WAIT_L(0); PG8_BAR; PG8_MMA(1, 0, At, B0); PG8_MMA(1, 1, At, B1); PG8_BAR; PG8_SCHED;
            PG8_LDB(B0, 1, 0); PG8_LDB(B1, 1, 1); PG8_SCHED; PG8_LDA(At, 1, 0); PG8_STAGE_A(PG8_SA(0, 1), a2 + hstepA, 1, last && has_next);
            PG8_WAIT_V(8); PG8_WAIT_L(0); PG8_BAR; PG8_MMA(0, 0, At, B0); PG8_MMA(0, 1, At, B1); PG8_BAR; PG8_SCHED;
            PG8_LDA(At, 1, 1); PG8_STAGE(PG8_SB(1, 0), b3, voffB); PG8_STAGE(PG8_SB(1, 1), b3 + hstep, voffB); PG8_STAGE_A(PG8_SA(1, 0), a3, 0, last && has_next);
            PG8_WAIT_V(8); PG8_WAIT_L(0); PG8_BAR; PG8_MMA(1, 0, At, B0); PG8_MMA(1, 1, At, B1); PG8_BAR; PG8_SCHED;
            } else {
            PG8_LDB(B0, 0, 0); PG8_SCHED; PG8_LDA(At, 0, 0); PG8_STAGE_A(PG8_SA(1, 1), a1 + hstepA, 1, false);
            PG8_WAIT_L(8); PG8_BAR; PG8_WAIT_L(0); PG8_MMA(0, 0, At, B0); PG8_BAR; PG8_SCHED;
            PG8_LDB(B1, 0, 1); PG8_STAGE(PG8_SB(0, 0), b2, voffB);
            PG8_BAR; PG8_WAIT_L(0); PG8_MMA(0, 1, At, B1); PG8_BAR;
            PG8_LDA(At, 0, 1); PG8_STAGE_A(PG8_SA(0, 0), a2, 0, last && has_next);
            PG8_BAR; PG8_WAIT_L(0); PG8_MMA(1, 0, At, B0); PG8_BAR; PG8_SCHED;
            PG8_STAGE(PG8_SB(0, 1), b2 + hstep, voffB);
            PG8_WAIT_V(6); PG8_BAR; PG8_MMA(1, 1, At, B1); PG8_BAR;
            PG8_LDB(B0, 1, 0); PG8_SCHED; PG8_LDA(At, 1, 0); PG8_STAGE_A(PG8_SA(0, 1), a2 + hstepA, 1, last && has_next);
            PG8_WAIT_L(8); PG8_BAR; PG8_WAIT_L(0); PG8_MMA(0, 0, At, B0); PG8_BAR; PG8_SCHED;
            PG8_LDB(B1, 1, 1); PG8_STAGE(PG8_SB(1, 0), b3, voffB);
            PG8_BAR; PG8_WAIT_L(0); PG8_MMA(0, 1, At, B1); PG8_BAR;
            PG8_LDA(At, 1, 1); PG8_STAGE_A(PG8_SA(1, 0), a3, 0, last && has_next);
            PG8_BAR; PG8_WAIT_L(0); PG8_MMA(1, 0, At, B0); PG8_BAR; PG8_SCHED;
            PG8_STAGE(PG8_SB(1, 1), b3 + hstep, voffB);
            PG8_WAIT_V(6); PG8_BAR; PG8_MMA(1, 1, At, B1); PG8_BAR;
            }
        }
        if constexpr (ALIGN_EPI) { if (wr == 0) PG8_BAR; }
        if constexpr (!Epi::AFTER_DRAIN) { E(acc, cur, wr, wc, fr, fq); S.done(cur); }
        if (!has_next) break;
#pragma unroll
        for (int a = 0; a < 2; ++a)
#pragma unroll
            for (int b = 0; b < 2; ++b)
#pragma unroll
                for (int m = 0; m < 4; ++m)
#pragma unroll
                    for (int n = 0; n < 2; ++n) acc[a][b][m][n] = (f32x4){0.f, 0.f, 0.f, 0.f};
        cur = nxt; cA = nA; cB = nB; ++ui;
        if constexpr (GATHER) { vGc[0][0] = vGn[0][0]; vGc[0][1] = vGn[0][1]; vGc[1][0] = vGn[1][0]; vGc[1][1] = vGn[1][1]; }
        if constexpr (ALIGN_EPI) { if (wr == 1) PG8_BAR; }
    }
    PG8_WAIT_V(0);
    if constexpr (!ALIGN_EPI) { if (wr == 0) PG8_BAR; }
    PG8_BAR;
    if constexpr (Epi::AFTER_DRAIN) { E.fused(acc, cur, wr, wc, fr, fq, lds, wid, lane); S.done(cur); }
#undef PG8_SA
#undef PG8_SB
#undef PG8_STAGE
#undef PG8_STAGE_A
#undef PG8_LDA
#undef PG8_LDB
#undef PG8_MMA
#undef PG8_WAIT_V
#undef PG8_WAIT_L
#undef PG8_BAR
#undef PG8_SCHED
}
}


namespace pg8 {
struct EpiBf16 {
    static constexpr bool PERM = true, AFTER_DRAIN = false;
    bf16_t* O; int ldc; int qtiles = 0; float qscale = 1.f;
    __device__ __forceinline__ void operator()(const f32x4 (&acc)[2][2][4][2], const Unit& u, int wr, int wc, int fr, int fq) const {
        const int row0 = u.pm * BM + wr * 64 + fr, col0 = u.pn * BM + wc * 32 + 8 * fq; const float sc_ = u.pn < qtiles ? qscale : 1.f;
#pragma unroll
        for (int ai = 0; ai < 2; ++ai)
#pragma unroll
            for (int m = 0; m < 4; ++m) { bf16_t* rowp = O + (size_t)(row0 + ai * HALF + m * 16) * ldc + col0;
#pragma unroll
                for (int bj = 0; bj < 2; ++bj) { const f32x4 v0 = acc[ai][bj][m][0] * sc_, v1 = acc[ai][bj][m][1] * sc_;
                    u32x4 w; w.x = cvt_pk_bf16(v0[0], v0[1]); w.y = cvt_pk_bf16(v0[2], v0[3]); w.z = cvt_pk_bf16(v1[0], v1[1]); w.w = cvt_pk_bf16(v1[2], v1[3]);
                    *(u32x4*)(rowp + bj * HALF) = w; } }
    }
};
struct EpiRopeBf16 {
    static constexpr bool PERM = true, AFTER_DRAIN = false;
    bf16_t* O; int ldc; const float* rope; int nrope; int qtiles; float qscale;
    __device__ __forceinline__ void operator()(const f32x4 (&acc)[2][2][4][2], const Unit& u, int wr, int wc, int fr, int fq) const {
        const int row0 = u.pm * BM + wr * 64 + fr, col0 = u.pn * BM + wc * 32 + 8 * fq;
        const bool do_rope = u.pn < nrope && u.pm >= 1;
        const float sc_ = u.pn < qtiles ? qscale : 1.f;
        const int cbase = 8 * (fq & 1); const bool x2side = fq >= 2; const bool colpos = wc & 1;
#pragma unroll
        for (int ai = 0; ai < 2; ++ai)
#pragma unroll
            for (int m = 0; m < 4; ++m) { const int row = row0 + ai * HALF + m * 16; bf16_t* rowp = O + (size_t)row * ldc + col0;
                f32x4 cs[4];
                if (do_rope) { const int t = row - 256, pos = colpos ? (t & 63) : (t >> 6); const f32x4* rp = (const f32x4*)(rope + (size_t)(pos * 16 + cbase) * 2);
#pragma unroll
                    for (int k = 0; k < 4; ++k) cs[k] = rp[k]; }
#pragma unroll
                for (int bj = 0; bj < 2; ++bj) { f32x4 v0 = acc[ai][bj][m][0] * sc_, v1 = acc[ai][bj][m][1] * sc_;
                    if (do_rope) { float e[8] = {v0[0], v0[1], v0[2], v0[3], v1[0], v1[1], v1[2], v1[3]};
#pragma unroll
                        for (int k = 0; k < 8; ++k) { auto rr = __builtin_amdgcn_permlane32_swap(__float_as_uint(e[k]), __float_as_uint(e[k]), false, false);
                            const float pr = __uint_as_float(x2side ? rr[0] : rr[1]); const float c_ = cs[k >> 1][(k & 1) * 2], s_ = cs[k >> 1][(k & 1) * 2 + 1];
                            e[k] = x2side ? e[k] * c_ + pr * s_ : e[k] * c_ - pr * s_; }
                        v0 = (f32x4){e[0], e[1], e[2], e[3]}; v1 = (f32x4){e[4], e[5], e[6], e[7]}; }
                    u32x4 w; w.x = cvt_pk_bf16(v0[0], v0[1]); w.y = cvt_pk_bf16(v0[2], v0[3]); w.z = cvt_pk_bf16(v1[0], v1[1]); w.w = cvt_pk_bf16(v1[2], v1[3]);
                    *(u32x4*)(rowp + bj * HALF) = w; } }
    }
};
struct EpiResid {
    static constexpr bool PERM = true, AFTER_DRAIN = false;
    bf16_t* X; const float* gate_lat; const float* gate_ctx; int row_off;
    __device__ __forceinline__ void operator()(const f32x4 (&acc)[2][2][4][2], const Unit& u, int wr, int wc, int fr, int fq) const {
        const int row0 = row_off + u.pm * BM + wr * 64 + fr, col0 = u.pn * BM + wc * 32 + 8 * fq;
        const float* gt = (row_off + u.pm * BM) < 256 ? gate_ctx : gate_lat;
        f32x4 gv[2][2];
#pragma unroll
        for (int bj = 0; bj < 2; ++bj)
#pragma unroll
            for (int n = 0; n < 2; ++n) gv[bj][n] = *(const f32x4*)(gt + col0 + bj * HALF + n * 4);
#pragma unroll
        for (int ai = 0; ai < 2; ++ai)
#pragma unroll
            for (int m = 0; m < 4; ++m) { bf16_t* rowp = X + (size_t)(row0 + ai * HALF + m * 16) * 1024 + col0;
#pragma unroll
                for (int bj = 0; bj < 2; ++bj) { u32x4* xp = (u32x4*)(rowp + bj * HALF); const u32x4 w = *xp;
                    const f32x4 x0 = {bflo(w.x), bfhi(w.x), bflo(w.y), bfhi(w.y)}, x1 = {bflo(w.z), bfhi(w.z), bflo(w.w), bfhi(w.w)};
                    const f32x4 v0 = x0 + gv[bj][0] * acc[ai][bj][m][0], v1 = x1 + gv[bj][1] * acc[ai][bj][m][1];
                    u32x4 o; o.x = cvt_pk_bf16(v0[0], v0[1]); o.y = cvt_pk_bf16(v0[2], v0[3]); o.z = cvt_pk_bf16(v1[0], v1[1]); o.w = cvt_pk_bf16(v1[2], v1[3]);
                    *xp = o; } }
    }
};
struct EpiSilu {
    static constexpr bool PERM = false, AFTER_DRAIN = false;
    bf16_t* Hd;
    __device__ __forceinline__ void operator()(const f32x4 (&acc)[2][2][4][2], const Unit& u, int wr, int wc, int fr, int fq) const {
        const int row0 = u.pm * BM + wr * 64 + fr, col0 = u.pn * 128 + wc * 16 + 4 * fq;
#pragma unroll
        for (int ai = 0; ai < 2; ++ai)
#pragma unroll
            for (int m = 0; m < 4; ++m) { bf16_t* rowp = Hd + (size_t)(row0 + ai * HALF + m * 16) * 512 + col0;
#pragma unroll
                for (int bj = 0; bj < 2; ++bj) { const f32x4 g = acc[ai][bj][m][0], up = acc[ai][bj][m][1]; float h[4];
#pragma unroll
                    for (int i = 0; i < 4; ++i) h[i] = g[i] * __builtin_amdgcn_rcpf(1.f + __expf(-g[i])) * up[i];
                    typedef unsigned u32x2v __attribute__((ext_vector_type(2))); u32x2v w; w.x = cvt_pk_bf16(h[0], h[1]); w.y = cvt_pk_bf16(h[2], h[3]);
                    *(u32x2v*)(rowp + bj * 64) = w; } }
    }
};
template <bool GA> struct MoeOrder {
    static constexpr bool GATHER = GA;
    const PG8_LAS unsigned char* t2e; int ntiles, ntn, G, c;
    const int* list; const PG8_LAS int* psl; const PG8_LAS int* cel; int lcap;
    __device__ __forceinline__ bool next(int i, Unit& u) const {
        const int L = i * G + c; if (L >= ntiles * ntn) return false;
        u.pm = L / ntn; u.pn = L % ntn; u.pb = (int)t2e[u.pm] * ntn + u.pn; return true;
    }
    __device__ __forceinline__ void load_rows(const Unit& u, const int (&Rr)[2], const int (&Cc)[2], int K, unsigned (&vo)[2][2]) const {
        const int e = (int)t2e[u.pm], lb = u.pm * 256 - psl[e], cnt = cel[e]; const int* le = list + (size_t)e * lcap;
#pragma unroll
        for (int h = 0; h < 2; ++h)
#pragma unroll
            for (int i = 0; i < 2; ++i) { const int lr = lb + h * 128 + Rr[i]; const int tok = lr < cnt ? le[lr] : 0; vo[h][i] = (unsigned)(tok * K + Cc[i]) * 2u; }
    }
    __device__ __forceinline__ void a_ready(const Unit&) const {}
    __device__ __forceinline__ void done(const Unit&) const {}
};
}

namespace att {
using bf16x8 = __attribute__((ext_vector_type(8))) short;
using s16x4 = __attribute__((ext_vector_type(4))) short;
using f32x16 = __attribute__((ext_vector_type(16))) float;
constexpr float SCALE = 0.125f, LOG2E = 1.4426950408889634f, C = SCALE * LOG2E, THR = 8.f;
#define ATT_SBAR() __builtin_amdgcn_sched_barrier(0)
__device__ __forceinline__ int crow(int r, int hi) { return (r & 3) + 8 * (r >> 2) + 4 * hi; }
__device__ __forceinline__ unsigned cvtpk(float lo, float hi) { unsigned r; asm volatile("v_cvt_pk_bf16_f32 %0, %1, %2" : "=v"(r) : "v"(lo), "v"(hi)); return r; }
__device__ __forceinline__ int kswz(int row, int colB) { return row * 128 + (colB ^ (((row >> 1) & 7) << 4)); }
template <int DV> __device__ __forceinline__ int v_st(int k, int c) { const int kk = (k & ~0xC) | ((k & 4) << 1) | ((k & 8) >> 1); return ((kk >> 3) * (DV / 32) + (c >> 5)) * 512 + ((kk & 7) * 32 + (c & 31)) * 2; }
__device__ __forceinline__ int v_rd_base(int lane) { return ((lane & 3) << 3) | (((lane >> 2) & 3) << 6) | (((lane >> 4) & 1) << 5) | (((lane >> 5) & 1) << 8); }
template <int DV> constexpr int v_rd_off(int d0, int ks, int half) { return d0 * 512 + ks * (DV / 32) * 1024 + half * (DV / 32) * 512; }
template <int OFF> __device__ __forceinline__ s16x4 tr_read(int vb) { s16x4 r; asm volatile("ds_read_b64_tr_b16 %0, %1 offset:%2" : "=&v"(r) : "v"(vb), "i"(OFF) : "memory"); return r; }

__device__ __forceinline__ void partialSM(f32x16& p0, f32x16& p1, float& m_reg, float& alpha) {
    float pmax = p0[0];
#pragma unroll
    for (int r = 1; r < 16; ++r) pmax = fmaxf(pmax, p0[r]);
#pragma unroll
    for (int r = 0; r < 16; ++r) pmax = fmaxf(pmax, p1[r]);
    { auto rr = __builtin_amdgcn_permlane32_swap(__float_as_uint(pmax), __float_as_uint(pmax), false, false); pmax = fmaxf(__uint_as_float(rr[0]), __uint_as_float(rr[1])); }
    float mn;
    if (__builtin_expect(__all(pmax - m_reg <= THR / SCALE), 1)) { mn = m_reg; alpha = 1.f; }
    else { mn = fmaxf(m_reg, pmax); alpha = __builtin_amdgcn_exp2f((m_reg - mn) * C); m_reg = mn; }
    const float mnC = -mn * C;
#pragma unroll
    for (int r = 0; r < 16; ++r) p0[r] = fmaf(p0[r], C, mnC);
#pragma unroll
    for (int r = 0; r < 16; ++r) p1[r] = fmaf(p1[r], C, mnC);
#pragma unroll
    for (int r = 0; r < 16; ++r) p0[r] = __builtin_amdgcn_exp2f(p0[r]);
}
__device__ __forceinline__ void partialSM_fixed(f32x16& p0, f32x16& p1, float mnC) {
#pragma unroll
    for (int r = 0; r < 16; ++r) p0[r] = fmaf(p0[r], C, mnC);
#pragma unroll
    for (int r = 0; r < 16; ++r) p1[r] = fmaf(p1[r], C, mnC);
#pragma unroll
    for (int r = 0; r < 16; ++r) p0[r] = __builtin_amdgcn_exp2f(p0[r]);
}
__device__ __forceinline__ void finishSM(f32x16& p0, f32x16& p1, float alpha, float& l_reg, bf16x8& pa0, bf16x8& pa1, bf16x8& pa2, bf16x8& pa3) {
#pragma unroll
    for (int r = 0; r < 16; ++r) p1[r] = __builtin_amdgcn_exp2f(p1[r]);
    float ps = 0;
#pragma unroll
    for (int r = 0; r < 16; ++r) ps += p0[r];
#pragma unroll
    for (int r = 0; r < 16; ++r) ps += p1[r];
    { auto rr = __builtin_amdgcn_permlane32_swap(__float_as_uint(ps), __float_as_uint(ps), false, false); ps = __uint_as_float(rr[0]) + __uint_as_float(rr[1]); }
    l_reg = l_reg * alpha + ps;
#define ATT_PK4(P, BASE, OUT) do { unsigned a0 = cvtpk(P[BASE + 0], P[BASE + 1]), a1 = cvtpk(P[BASE + 2], P[BASE + 3]);   \
    unsigned b0 = cvtpk(P[BASE + 4], P[BASE + 5]), b1 = cvtpk(P[BASE + 6], P[BASE + 7]);                              \
    auto r0 = __builtin_amdgcn_permlane32_swap(a0, b0, false, false); auto r1 = __builtin_amdgcn_permlane32_swap(a1, b1, false, false); \
    u32x4 w = {r0[0], r1[0], r0[1], r1[1]}; OUT = *reinterpret_cast<bf16x8*>(&w); } while (0)
    ATT_PK4(p0, 0, pa0); ATT_PK4(p0, 8, pa1); ATT_PK4(p1, 0, pa2); ATT_PK4(p1, 8, pa3);
#undef ATT_PK4
}
__device__ __forceinline__ void qkt(f32x16& p0, f32x16& p1, const char* Ks, const bf16x8* qr, int r32, int hi) {
    p0 = f32x16{}; p1 = f32x16{};
#pragma unroll
    for (int d0 = 0; d0 < 4; ++d0) { const int cb = (d0 * 16 + hi * 8) * 2;
        const bf16x8 b0 = *reinterpret_cast<const bf16x8*>(Ks + kswz(r32, cb));
        const bf16x8 b1 = *reinterpret_cast<const bf16x8*>(Ks + kswz(32 + r32, cb));
        p0 = __builtin_amdgcn_mfma_f32_32x32x16_bf16(b0, qr[d0], p0, 0, 0, 0);
        p1 = __builtin_amdgcn_mfma_f32_32x32x16_bf16(b1, qr[d0], p1, 0, 0, 0); }
}
__device__ __forceinline__ void qkt_init(f32x16& p0, f32x16& p1, const char* Ks, const bf16x8* qr, const f32x16& cinit, int r32, int hi) {
#pragma unroll
    for (int d0 = 0; d0 < 4; ++d0) { const int cb = (d0 * 16 + hi * 8) * 2;
        const bf16x8 b0 = *reinterpret_cast<const bf16x8*>(Ks + kswz(r32, cb));
        const bf16x8 b1 = *reinterpret_cast<const bf16x8*>(Ks + kswz(32 + r32, cb));
        if (d0 == 0) { p0 = __builtin_amdgcn_mfma_f32_32x32x16_bf16(b0, qr[0], cinit, 0, 0, 0); p1 = __builtin_amdgcn_mfma_f32_32x32x16_bf16(b1, qr[0], cinit, 0, 0, 0); }
        else { p0 = __builtin_amdgcn_mfma_f32_32x32x16_bf16(b0, qr[d0], p0, 0, 0, 0); p1 = __builtin_amdgcn_mfma_f32_32x32x16_bf16(b1, qr[d0], p1, 0, 0, 0); } }
}
template <int DV, int D0> __device__ __forceinline__ void pv_one(f32x16& od, int vb, bf16x8 pa0, bf16x8 pa1, bf16x8 pa2, bf16x8 pa3) {
    const s16x4 l0 = tr_read<v_rd_off<DV>(D0, 0, 0)>(vb), h0 = tr_read<v_rd_off<DV>(D0, 0, 1)>(vb), l1 = tr_read<v_rd_off<DV>(D0, 1, 0)>(vb), h1 = tr_read<v_rd_off<DV>(D0, 1, 1)>(vb);
    const s16x4 l2 = tr_read<v_rd_off<DV>(D0, 2, 0)>(vb), h2 = tr_read<v_rd_off<DV>(D0, 2, 1)>(vb), l3 = tr_read<v_rd_off<DV>(D0, 3, 0)>(vb), h3 = tr_read<v_rd_off<DV>(D0, 3, 1)>(vb);
    asm volatile("s_waitcnt lgkmcnt(0)" ::: "memory"); ATT_SBAR();
#define ATT_PK(L, H) (bf16x8){L[0], L[1], L[2], L[3], H[0], H[1], H[2], H[3]}
    od = __builtin_amdgcn_mfma_f32_32x32x16_bf16(pa0, ATT_PK(l0, h0), od, 0, 0, 0);
    od = __builtin_amdgcn_mfma_f32_32x32x16_bf16(pa1, ATT_PK(l1, h1), od, 0, 0, 0);
    od = __builtin_amdgcn_mfma_f32_32x32x16_bf16(pa2, ATT_PK(l2, h2), od, 0, 0, 0);
    od = __builtin_amdgcn_mfma_f32_32x32x16_bf16(pa3, ATT_PK(l3, h3), od, 0, 0, 0);
#undef ATT_PK
}
template <int DV> __device__ __forceinline__ void pv_all(f32x16* o, int vb, bf16x8 pa0, bf16x8 pa1, bf16x8 pa2, bf16x8 pa3) {
    pv_one<DV, 0>(o[0], vb, pa0, pa1, pa2, pa3); pv_one<DV, 1>(o[1], vb, pa0, pa1, pa2, pa3);
    if constexpr (DV == 128) { pv_one<DV, 2>(o[2], vb, pa0, pa1, pa2, pa3); pv_one<DV, 3>(o[3], vb, pa0, pa1, pa2, pa3); }
}
struct VFrag64 { s16x4 l[2][4], h[2][4]; };
__device__ __forceinline__ void vfrag_read64(VFrag64& f, int vb) {
    f.l[0][0] = tr_read<v_rd_off<64>(0, 0, 0)>(vb); f.h[0][0] = tr_read<v_rd_off<64>(0, 0, 1)>(vb); f.l[0][1] = tr_read<v_rd_off<64>(0, 1, 0)>(vb); f.h[0][1] = tr_read<v_rd_off<64>(0, 1, 1)>(vb);
    f.l[0][2] = tr_read<v_rd_off<64>(0, 2, 0)>(vb); f.h[0][2] = tr_read<v_rd_off<64>(0, 2, 1)>(vb); f.l[0][3] = tr_read<v_rd_off<64>(0, 3, 0)>(vb); f.h[0][3] = tr_read<v_rd_off<64>(0, 3, 1)>(vb);
    f.l[1][0] = tr_read<v_rd_off<64>(1, 0, 0)>(vb); f.h[1][0] = tr_read<v_rd_off<64>(1, 0, 1)>(vb); f.l[1][1] = tr_read<v_rd_off<64>(1, 1, 0)>(vb); f.h[1][1] = tr_read<v_rd_off<64>(1, 1, 1)>(vb);
    f.l[1][2] = tr_read<v_rd_off<64>(1, 2, 0)>(vb); f.h[1][2] = tr_read<v_rd_off<64>(1, 2, 1)>(vb); f.l[1][3] = tr_read<v_rd_off<64>(1, 3, 0)>(vb); f.h[1][3] = tr_read<v_rd_off<64>(1, 3, 1)>(vb);
}
__device__ __forceinline__ void pv_frag64(f32x16* o, const VFrag64& f, bf16x8 pa0, bf16x8 pa1, bf16x8 pa2, bf16x8 pa3) {
#define ATT_PK(L, H) (bf16x8){L[0], L[1], L[2], L[3], H[0], H[1], H[2], H[3]}
    o[0] = __builtin_amdgcn_mfma_f32_32x32x16_bf16(pa0, ATT_PK(f.l[0][0], f.h[0][0]), o[0], 0, 0, 0);
    o[1] = __builtin_amdgcn_mfma_f32_32x32x16_bf16(pa0, ATT_PK(f.l[1][0], f.h[1][0]), o[1], 0, 0, 0);
    o[0] = __builtin_amdgcn_mfma_f32_32x32x16_bf16(pa1, ATT_PK(f.l[0][1], f.h[0][1]), o[0], 0, 0, 0);
    o[1] = __builtin_amdgcn_mfma_f32_32x32x16_bf16(pa1, ATT_PK(f.l[1][1], f.h[1][1]), o[1], 0, 0, 0);
    o[0] = __builtin_amdgcn_mfma_f32_32x32x16_bf16(pa2, ATT_PK(f.l[0][2], f.h[0][2]), o[0], 0, 0, 0);
    o[1] = __builtin_amdgcn_mfma_f32_32x32x16_bf16(pa2, ATT_PK(f.l[1][2], f.h[1][2]), o[1], 0, 0, 0);
    o[0] = __builtin_amdgcn_mfma_f32_32x32x16_bf16(pa3, ATT_PK(f.l[0][3], f.h[0][3]), o[0], 0, 0, 0);
    o[1] = __builtin_amdgcn_mfma_f32_32x32x16_bf16(pa3, ATT_PK(f.l[1][3], f.h[1][3]), o[1], 0, 0, 0);
#undef ATT_PK
}
template <int DV> struct Lds { static constexpr int SHM_V = 64 * DV * 2, SHM_K = 8192, V0 = 0, K0 = 2 * SHM_V, WSF = K0 + 2 * SHM_K, STG = WSF + 2048, BIAS = STG + 8 * 32 * DV * 2, END = BIAS + 2048; };

struct MaskP { int mode; int qpos; int kpos0; int qr, qc, r0, c0, rb; const float* bias_l; };
template <int MODE> __device__ __forceinline__ void apply_mask(f32x16& p0, f32x16& p1, int t, const MaskP& mk, int hi) {
    if (MODE == 0 || t < 4) return;
    if (MODE == 1) { const int d0 = mk.kpos0 + 64 * (t - 4) - mk.qpos + 128 + 4 * hi;
#pragma unroll
        for (int r = 0; r < 16; ++r) { const int d = d0 + (r & 3) + 8 * (r >> 2);
            if ((unsigned)d > 256u) p0[r] = -INFINITY; if ((unsigned)(d + 32) > 256u) p1[r] = -INFINITY; } }
    if (MODE == 2) { const int kr = mk.rb + (t - 4);
        if (kr < mk.r0 || kr >= mk.r0 + 8) {
#pragma unroll
            for (int r = 0; r < 16; ++r) { p0[r] = -INFINITY; p1[r] = -INFINITY; } }
        else { const int base = (kr - mk.qr + 7) * 31 - mk.qc + 15 + 4 * hi, dc0 = 4 * hi - mk.c0;
#pragma unroll
            for (int r = 0; r < 16; ++r) { const int kc = (r & 3) + 8 * (r >> 2);
                const bool v0 = (unsigned)(dc0 + kc) < 16u, v1 = (unsigned)(dc0 + kc + 32) < 16u;
                const float b0 = mk.bias_l[v0 ? base + kc : 0], b1 = mk.bias_l[v1 ? base + kc + 32 : 0];
                p0[r] = v0 ? p0[r] + b0 : -INFINITY; p1[r] = v1 ? p1[r] + b1 : -INFINITY;
                if ((r & 3) == 3) asm volatile("" ::: "memory"); } } }
}

template <int DV, int MODE, int SDEPTH = 2>
__device__ __forceinline__ void attn_core(const bf16* __restrict__ QKV, int LD, int qrow0, int qoff, int koff, int voff, int NT, int kbase, const MaskP& mk, char* lds,
                                          f32x16 (&o)[DV / 32], float& l_out, float& m_out) {
    using LM = Lds<DV>;
    const int tid = threadIdx.x, wid = tid >> 6, lane = tid & 63, r32 = lane & 31, hi = lane >> 5;
    char* V_lds = lds + LM::V0; char* K_lds = lds + LM::K0;
    float* al_l = (float*)(lds + LM::WSF) + wid * 64 + 32;
    float m_reg = -1e30f, l_reg = 0.f; bf16x8 qr[4];
#pragma unroll
    for (int d = 0; d < DV / 32; ++d) o[d] = f32x16{};
    const bf16* Qw = QKV + (size_t)(qrow0 + wid * 32 + r32) * LD + qoff + hi * 8;
#pragma unroll
    for (int d0 = 0; d0 < 4; ++d0) qr[d0] = *reinterpret_cast<const bf16x8*>(Qw + d0 * 16);
    const bf16* Kp = QKV + koff; const bf16* Vp = QKV + voff;
    const int ksr = tid >> 3, kc8 = (tid & 7) * 8, kst = kswz(ksr, kc8 * 2);
    const int vsr = DV == 64 ? (tid >> 3) : (tid >> 4), vsc = DV == 64 ? (tid & 7) * 8 : (tid & 15) * 8;
    const int vst0 = v_st<DV>(vsr, vsc), vst1 = v_st<DV>(32 + vsr, vsc);
    const int vb0 = (int)(uintptr_t)V_lds + v_rd_base(lane);
    struct { bf16x8 k, v0, v1; } sr_[SDEPTH];
#define ATT_K0(t) ((t) < 4 ? 64 * (t) : kbase + 64 * ((t) - 4))
#define ATT_SLOAD(i, t) do { const int k0_ = ATT_K0(t); sr_[i].k = *reinterpret_cast<const bf16x8*>(Kp + (size_t)(k0_ + ksr) * LD + kc8); \
    sr_[i].v0 = *reinterpret_cast<const bf16x8*>(Vp + (size_t)(k0_ + vsr) * LD + vsc); \
    if constexpr (DV == 128) sr_[i].v1 = *reinterpret_cast<const bf16x8*>(Vp + (size_t)(k0_ + 32 + vsr) * LD + vsc); } while (0)
#define ATT_SWRITE(b, i) do { *(bf16x8*)(K_lds + (b) * LM::SHM_K + kst) = sr_[i].k; *(bf16x8*)(V_lds + (b) * LM::SHM_V + vst0) = sr_[i].v0; \
    if constexpr (DV == 128) *(bf16x8*)(V_lds + (b) * LM::SHM_V + vst1) = sr_[i].v1; } while (0)
#define ATT_SWAIT() do { if constexpr (SDEPTH == 1) asm volatile("s_waitcnt vmcnt(0)" ::: "memory"); else if constexpr (DV == 128) asm volatile("s_waitcnt vmcnt(3)" ::: "memory"); else asm volatile("s_waitcnt vmcnt(2)" ::: "memory"); } while (0)
#define ATT_RESC(a) do { if (__any((a) < 1.f)) { if (hi == 0) al_l[r32] = (a); asm volatile("s_waitcnt lgkmcnt(0)" ::: "memory"); \
    _Pragma("unroll") for (int d = 0; d < DV / 32; ++d) _Pragma("unroll") for (int r = 0; r < 16; ++r) o[d][r] *= al_l[crow(r, hi)]; } } while (0)
    f32x16 pA0, pA1, pB0, pB1; float alA, alB; bf16x8 pa0, pa1, pa2, pa3;
    constexpr int SE = 0, SO = SDEPTH - 1;
    ATT_SLOAD(SE, 0); asm volatile("s_waitcnt vmcnt(0)" ::: "memory"); ATT_SWRITE(0, SE); __syncthreads();
    qkt(pA0, pA1, K_lds, qr, r32, hi); apply_mask<MODE>(pA0, pA1, 0, mk, hi); partialSM(pA0, pA1, m_reg, alA);
    ATT_SLOAD(SO, 1); if constexpr (SDEPTH == 2) { if (2 < NT) ATT_SLOAD(SE, 2); }
    ATT_SWAIT(); ATT_SWRITE(1, SO); __syncthreads();
    for (int j = 1; j + 1 < NT; j += 2) {
        ATT_SBAR(); qkt(pB0, pB1, K_lds + LM::SHM_K, qr, r32, hi);
        finishSM(pA0, pA1, alA, l_reg, pa0, pa1, pa2, pa3); ATT_SBAR();
        ATT_SLOAD(SO, j + SDEPTH); ATT_SBAR();
        pv_all<DV>(o, vb0, pa0, pa1, pa2, pa3); apply_mask<MODE>(pB0, pB1, j, mk, hi); partialSM(pB0, pB1, m_reg, alB);
        __syncthreads(); ATT_SWAIT(); ATT_SWRITE(0, SE);
        ATT_RESC(alB); __syncthreads();
        ATT_SBAR(); qkt(pA0, pA1, K_lds, qr, r32, hi);
        finishSM(pB0, pB1, alB, l_reg, pa0, pa1, pa2, pa3); ATT_SBAR();
        if (SDEPTH == 1 || j + 3 < NT) ATT_SLOAD(SE, j + 1 + SDEPTH); ATT_SBAR();
        pv_all<DV>(o, vb0 + LM::SHM_V, pa0, pa1, pa2, pa3); apply_mask<MODE>(pA0, pA1, j + 1, mk, hi); partialSM(pA0, pA1, m_reg, alA);
        __syncthreads(); ATT_SWAIT(); ATT_SWRITE(1, SO);
        ATT_RESC(alA); __syncthreads();
    }
    ATT_SBAR(); qkt(pB0, pB1, K_lds + LM::SHM_K, qr, r32, hi);
    finishSM(pA0, pA1, alA, l_reg, pa0, pa1, pa2, pa3); ATT_SBAR();
    pv_all<DV>(o, vb0, pa0, pa1, pa2, pa3); apply_mask<MODE>(pB0, pB1, NT - 1, mk, hi); partialSM(pB0, pB1, m_reg, alB);
    __syncthreads(); ATT_RESC(alB);
    finishSM(pB0, pB1, alB, l_reg, pa0, pa1, pa2, pa3); ATT_SBAR();
    pv_all<DV>(o, vb0 + LM::SHM_V, pa0, pa1, pa2, pa3);
    l_out = l_reg; m_out = m_reg;
#undef ATT_K0
#undef ATT_SLOAD
#undef ATT_SWRITE
#undef ATT_SWAIT
#undef ATT_RESC
}
template <int DV> struct Lds2 { static constexpr int SHM_V = 64 * DV * 2, SHM_K = 8192, K0 = 0, V0 = 3 * SHM_K, WSF = V0 + 3 * SHM_V, STG = WSF + 2048, BIAS = STG + 8 * 32 * DV * 2, END = BIAS + 2048; };
__device__ __forceinline__ void glds16(const void* gsrc, unsigned lds_dst) { unsigned keep;
    asm volatile("s_mov_b32 %0, m0\n\ts_mov_b32 m0, %2\n\ts_nop 0\n\tglobal_load_lds_dwordx4 %1, off\n\ts_mov_b32 m0, %0" : "=&s"(keep) : "v"(gsrc), "s"(lds_dst) : "memory"); }
__device__ __forceinline__ void glds16o(const void* sbase, unsigned voff, unsigned lds_dst) { unsigned keep;
    asm volatile("s_mov_b32 %0, m0\n\ts_mov_b32 m0, %3\n\ts_nop 0\n\tglobal_load_lds_dwordx4 %1, %2\n\ts_mov_b32 m0, %0" : "=&s"(keep) : "v"(voff), "s"(sbase), "s"(lds_dst) : "memory"); }
#define ATT_WAITBAR(N) asm volatile("s_waitcnt vmcnt(" #N ") lgkmcnt(0)\n\ts_barrier" ::: "memory")
template <int DV, int MODE, int FIXM = 0>
__device__ __forceinline__ void attn_core2(const bf16* __restrict__ QKV, int LD, int qrow0, int qoff, int koff, int voff, int NT, int kbase, const MaskP& mk, char* lds,
                                           f32x16 (&o)[DV / 32], float& l_out, float& m_out, float mfix = 0.f) {
    using LM = Lds2<DV>; constexpr int NV = DV / 64;
    const int tid = threadIdx.x, wid = __builtin_amdgcn_readfirstlane(tid >> 6), lane = tid & 63, r32 = lane & 31, hi = lane >> 5;
    const unsigned lds0 = (unsigned)(uintptr_t)lds;
    char* K_lds = lds + LM::K0;
    float* al_l = (float*)(lds + LM::WSF) + wid * 64 + 32;
    float m_reg = FIXM ? mfix : -1e30f, l_reg = 0.f; bf16x8 qr[4]; float mnCf = -mfix * C;
#pragma unroll
    for (int d = 0; d < DV / 32; ++d) o[d] = f32x16{};
    const int krow = 8 * wid + (lane >> 3), kch = (lane & 7) ^ ((krow >> 1) & 7);
    const unsigned ksrc = (unsigned)(krow * LD + kch * 8) * 2u; const bf16* kbase_p = QKV + koff;
    const unsigned kdst = lds0 + LM::K0 + wid * 1024;
    unsigned vsrc0; unsigned vdst0; const bf16* vbase_p = QKV + voff;
    { const int pc = wid, sub = 2 * pc + (lane >> 5), within = lane & 31, kk = (sub / (DV / 32)) * 8 + (within >> 2), cc = (sub % (DV / 32)) * 32 + (within & 3) * 8;
      const int k = (kk & ~0xC) | ((kk & 4) << 1) | ((kk & 8) >> 1);
      vsrc0 = (unsigned)(k * LD + cc) * 2u; vdst0 = lds0 + LM::V0 + pc * 1024; }
#define ATT_K0(t) ((t) < 4 ? 64 * (t) : kbase + 64 * ((t) - 4))
#define ATT_DMA_K(t, slot) glds16o(kbase_p + (size_t)ATT_K0(t) * LD, ksrc, (unsigned)__builtin_amdgcn_readfirstlane(kdst + (slot) * LM::SHM_K))
#define ATT_DMA_V(t, slot) do { _Pragma("unroll") for (int i_ = 0; i_ < NV; ++i_) glds16o(vbase_p + (size_t)(ATT_K0(t) + 32 * i_) * LD, vsrc0, (unsigned)__builtin_amdgcn_readfirstlane(vdst0 + i_ * 8192 + (slot) * LM::SHM_V)); } while (0)
#define ATT_RESC(a) do { if (__any((a) < 1.f)) { if (hi == 0) al_l[r32] = (a); asm volatile("s_waitcnt lgkmcnt(0)" ::: "memory"); \
    _Pragma("unroll") for (int d = 0; d < DV / 32; ++d) _Pragma("unroll") for (int r = 0; r < 16; ++r) o[d][r] *= al_l[crow(r, hi)]; } } while (0)
    const int vb0 = (int)(lds0 + LM::V0) + v_rd_base(lane);
    ATT_DMA_K(0, 0); ATT_DMA_V(0, 0); ATT_DMA_K(1, 1);
    const bf16* Qw = QKV + (size_t)(qrow0 + wid * 32 + r32) * LD + qoff + hi * 8;
#pragma unroll
    for (int d0 = 0; d0 < 4; ++d0) qr[d0] = *reinterpret_cast<const bf16x8*>(Qw + d0 * 16);
    constexpr bool NEGM = (FIXM == 1 && DV == 64);
    f32x16 negm = f32x16{};
    if constexpr (NEGM) {
#pragma unroll
        for (int d0 = 0; d0 < 4; ++d0) { u32x4 w;
#pragma unroll
            for (int j = 0; j < 4; ++j) w[j] = cvtpk(bf2f((unsigned short)qr[d0][2 * j]) * C, bf2f((unsigned short)qr[d0][2 * j + 1]) * C);
            qr[d0] = *reinterpret_cast<bf16x8*>(&w); }
#pragma unroll
        for (int r = 0; r < 16; ++r) negm[r] = mnCf;
        asm volatile("" : "+v"(negm)); }
    if constexpr (FIXM == 2) {
        float qn2 = 0.f;
#pragma unroll
        for (int d0 = 0; d0 < 4; ++d0)
#pragma unroll
            for (int j = 0; j < 8; ++j) { const float v = bf2f((unsigned short)qr[d0][j]); qn2 += v * v; }
        { auto rr = __builtin_amdgcn_permlane32_swap(__float_as_uint(qn2), __float_as_uint(qn2), false, false); qn2 = __uint_as_float(rr[0]) + __uint_as_float(rr[1]); }
        m_reg = sqrtf(qn2) * mfix * (0.125f * 1.01f); mnCf = -m_reg * C; }
    ATT_WAITBAR(0);
    f32x16 pA0, pA1, pB0, pB1; float alA, alB; bf16x8 pa0, pa1, pa2, pa3;
    ATT_DMA_K(2, 2); ATT_DMA_V(1, 1);
    if constexpr (NEGM) { qkt_init(pA0, pA1, K_lds, qr, negm, r32, hi); alA = 1.f; alB = 1.f;
#pragma unroll
        for (int r = 0; r < 16; ++r) pA0[r] = __builtin_amdgcn_exp2f(pA0[r]); }
    else { qkt(pA0, pA1, K_lds, qr, r32, hi); apply_mask<MODE>(pA0, pA1, 0, mk, hi);
        if constexpr (FIXM != 0) { partialSM_fixed(pA0, pA1, mnCf); alA = 1.f; alB = 1.f; } else partialSM(pA0, pA1, m_reg, alA); }
    int s_tm1 = 0, s_t = 1, s_tp1 = 2;
    int w_lo = 0, w_hi = 0;
    if constexpr (MODE == 1) { const int qw = __builtin_amdgcn_readfirstlane(mk.qpos), k0l = __builtin_amdgcn_readfirstlane(mk.kpos0);
        w_lo = (qw - 128 - k0l) >> 6; w_hi = (qw + 31 + 128 - k0l) >> 6; }
    if constexpr (MODE == 2) { const int r0u = __builtin_amdgcn_readfirstlane(mk.r0), rbu = __builtin_amdgcn_readfirstlane(mk.rb); w_lo = r0u - rbu; w_hi = r0u + 7 - rbu; }
#define ATT_ACT(tt) (MODE == 0 || (tt) < 4 || ((tt) - 4 >= w_lo && (tt) - 4 <= w_hi))
#define ATT_STEP(t, PX0, PX1, ALX, ACX, PY0, PY1, ALY, ACY, FULLWAIT, HASK, HASV) do { \
        if (FULLWAIT) ATT_WAITBAR(0); else if constexpr (NV == 1) ATT_WAITBAR(2); else ATT_WAITBAR(3); \
        if (HASK) ATT_DMA_K((t) + 2, s_tm1); if (HASV) ATT_DMA_V((t) + 1, s_tp1); \
        ACX = ATT_ACT(t); \
        ATT_SBAR(); \
        if (ACX) { if constexpr (NEGM) qkt_init(PX0, PX1, K_lds + s_t * LM::SHM_K, qr, negm, r32, hi); else qkt(PX0, PX1, K_lds + s_t * LM::SHM_K, qr, r32, hi); } \
        if (ACY) { finishSM(PY0, PY1, ALY, l_reg, pa0, pa1, pa2, pa3); ATT_SBAR(); \
            pv_all<DV>(o, vb0 + s_tm1 * LM::SHM_V, pa0, pa1, pa2, pa3); } \
        if (ACX) { apply_mask<MODE>(PX0, PX1, (t), mk, hi); \
            if constexpr (NEGM) { _Pragma("unroll") for (int r_ = 0; r_ < 16; ++r_) PX0[r_] = __builtin_amdgcn_exp2f(PX0[r_]); } \
            else if constexpr (FIXM != 0) partialSM_fixed(PX0, PX1, mnCf); else { partialSM(PX0, PX1, m_reg, ALX); ATT_RESC(ALX); } } \
        { const int tmp_ = s_tm1; s_tm1 = s_t; s_t = s_tp1; s_tp1 = tmp_; } } while (0)
    bool acA = true, acB = true;
    int t = 1;
    for (; t <= NT - 5; t += 2) {
        ATT_STEP(t, pB0, pB1, alB, acB, pA0, pA1, alA, acA, false, true, true);
        ATT_STEP(t + 1, pA0, pA1, alA, acA, pB0, pB1, alB, acB, false, true, true);
    }
    ATT_STEP(t, pB0, pB1, alB, acB, pA0, pA1, alA, acA, false, true, true);
    ATT_STEP(t + 1, pA0, pA1, alA, acA, pB0, pB1, alB, acB, false, false, true);
    ATT_STEP(t + 2, pB0, pB1, alB, acB, pA0, pA1, alA, acA, true, false, false);
    if (acB) { finishSM(pB0, pB1, alB, l_reg, pa0, pa1, pa2, pa3); ATT_SBAR();
        pv_all<DV>(o, vb0 + s_tm1 * LM::SHM_V, pa0, pa1, pa2, pa3); }
    asm volatile("s_waitcnt lgkmcnt(0)\n\ts_barrier" ::: "memory");
    l_out = l_reg; m_out = m_reg;
#undef ATT_K0
#undef ATT_DMA_K
#undef ATT_DMA_V
#undef ATT_RESC
#undef ATT_STEP
#undef ATT_ACT
}
__device__ __forceinline__ void bcast_rows(float v, float (&out)[16], char* wsf_base, int wid, int r32, int hi) {
    float* li_l = (float*)wsf_base + wid * 64;
    if (hi == 0) li_l[r32] = v;
    asm volatile("s_waitcnt lgkmcnt(0)" ::: "memory");
#pragma unroll
    for (int r = 0; r < 16; ++r) out[r] = li_l[crow(r, hi)];
    asm volatile("s_waitcnt lgkmcnt(0)" ::: "memory");
}
template <int DV> __device__ __forceinline__ void store_tile(const f32x16 (&o)[DV / 32], bf16* Orow0, char* lds, int wid, int lane) {
    const int r32 = lane & 31, hi = lane >> 5;
    bf16* stg = (bf16*)(lds + Lds2<DV>::STG) + wid * 32 * DV;
#pragma unroll
    for (int r = 0; r < 16; ++r) { const int orow = crow(r, hi);
#pragma unroll
        for (int d0 = 0; d0 < DV / 32; ++d0) stg[orow * DV + d0 * 32 + r32] = (bf16)f2bf(o[d0][r]); }
    asm volatile("s_waitcnt lgkmcnt(0)" ::: "memory");
    constexpr int CPR = DV / 8;
#pragma unroll
    for (int i = 0; i < 32 * CPR / 64; ++i) { const int idx = i * 64 + lane, row = idx / CPR, ch = idx % CPR;
        const u32x4 v = *(const u32x4*)(stg + row * DV + ch * 8); *(u32x4*)(Orow0 + (size_t)row * 1024 + ch * 8) = v; }
    asm volatile("s_waitcnt lgkmcnt(0)" ::: "memory");
}
}

namespace att64 {
using bf16x8=__attribute__((ext_vector_type(8)))short;
using s16x4=__attribute__((ext_vector_type(4)))short;
using f32x16=__attribute__((ext_vector_type(16)))float;
constexpr int D=64,NW=8,QBLK=32,QB=QBLK*NW,KVBLK=64;
__device__ __forceinline__ int crow(int r,int hi){return (r&3)+8*(r>>2)+4*hi;}
#define SBAR() __builtin_amdgcn_sched_barrier(0)
constexpr int NSLOT=3, SLOTB=8192;
constexpr int LDS_K=0, LDS_V=NSLOT*SLOTB, LDS_WS=2*NSLOT*SLOTB, LDS_OST=LDS_WS+NW*64*4, LDS_BIAS=LDS_OST+NW*4096, LDS_BYTES=LDS_BIAS+2048;
constexpr float C2=0.125f*1.4426950408889634f;
__device__ __forceinline__ void glds16(const void*gsrc,unsigned lds_dst){unsigned keep;
  asm volatile("s_mov_b32 %0, m0\n\ts_mov_b32 m0, %2\n\ts_nop 0\n\tglobal_load_lds_dwordx4 %1, off\n\ts_mov_b32 m0, %0":"=&s"(keep):"v"(gsrc),"s"(lds_dst):"memory");}
__device__ __forceinline__ float max3f(float a,float b,float c){float r;asm("v_max3_f32 %0, %1, %2, %3":"=v"(r):"v"(a),"v"(b),"v"(c));return r;}
__device__ __forceinline__ float max2f(float a,float b){float r;asm("v_max_f32_e32 %0, %1, %2":"=v"(r):"v"(a),"v"(b));return r;}
__device__ __forceinline__ float fadd_s(float a,float b){float r;asm("v_add_f32_e32 %0, %1, %2":"=v"(r):"v"(a),"v"(b));return r;}
__device__ __forceinline__ float fsub_s(float a,float b){float r;asm("v_sub_f32_e32 %0, %1, %2":"=v"(r):"v"(a),"v"(b));return r;}
typedef float f32x2_t __attribute__((ext_vector_type(2))); typedef __bf16 bf16x2_t __attribute__((ext_vector_type(2)));
__device__ __forceinline__ unsigned cvtpk_s(float lo,float hi){f32x2_t v={lo,hi};bf16x2_t b=__builtin_convertvector(v,bf16x2_t);return __builtin_bit_cast(unsigned,b);}
#define WAIT_BAR(N) asm volatile("s_waitcnt vmcnt(" #N ") lgkmcnt(0)\n\ts_barrier":::"memory")

__device__ __forceinline__ void qkt(f32x16&p0,f32x16&p1,const char*Kslot,const bf16x8*qr,const f32x16&negm,int r32,int hi){
  const char*kb=Kslot+hi*1024+r32*16;
  #pragma unroll
  for(int d0=0;d0<4;++d0){
    const bf16x8 b0=*reinterpret_cast<const bf16x8*>(kb+d0*2048);
    const bf16x8 b1=*reinterpret_cast<const bf16x8*>(kb+d0*2048+512);
    if(d0==0){p0=__builtin_amdgcn_mfma_f32_32x32x16_bf16(b0,qr[0],negm,0,0,0);p1=__builtin_amdgcn_mfma_f32_32x32x16_bf16(b1,qr[0],negm,0,0,0);}
    else{p0=__builtin_amdgcn_mfma_f32_32x32x16_bf16(b0,qr[d0],p0,0,0,0);p1=__builtin_amdgcn_mfma_f32_32x32x16_bf16(b1,qr[d0],p1,0,0,0);}}
}
typedef __attribute__((address_space(3))) const char* lds_cptr;
typedef short v4i16_t __attribute__((ext_vector_type(4)));
__device__ __forceinline__ void kload8(bf16x8*kf,lds_cptr kp){
  kf[0]=*(const __attribute__((address_space(3))) bf16x8*)(kp);      kf[1]=*(const __attribute__((address_space(3))) bf16x8*)(kp+512);
  kf[2]=*(const __attribute__((address_space(3))) bf16x8*)(kp+2048); kf[3]=*(const __attribute__((address_space(3))) bf16x8*)(kp+2560);
  kf[4]=*(const __attribute__((address_space(3))) bf16x8*)(kp+4096); kf[5]=*(const __attribute__((address_space(3))) bf16x8*)(kp+4608);
  kf[6]=*(const __attribute__((address_space(3))) bf16x8*)(kp+6144); kf[7]=*(const __attribute__((address_space(3))) bf16x8*)(kp+6656);
}
__device__ __forceinline__ void kload2(bf16x8*kf,lds_cptr kp,int j){ kf[2*j]=*(const __attribute__((address_space(3))) bf16x8*)(kp+j*2048); kf[2*j+1]=*(const __attribute__((address_space(3))) bf16x8*)(kp+j*2048+512); }
__device__ __forceinline__ s16x4 vtr(lds_cptr p){ return __builtin_bit_cast(s16x4,__builtin_amdgcn_ds_read_tr16_b64_v4i16((__attribute__((address_space(3))) v4i16_t*)p)); }
__device__ __forceinline__ float rowmax(const f32x16&p0,const f32x16&p1){
  float a=max3f(p0[0],p0[1],p1[0]),b=max3f(p0[2],p0[3],p1[1]);a=max3f(a,p1[2],p1[3]);
  #pragma unroll
  for(int r=4;r<16;r+=4){a=max3f(a,p0[r],p0[r+1]);b=max3f(b,p0[r+2],p0[r+3]);a=max3f(a,p1[r],p1[r+1]);b=max3f(b,p1[r+2],p1[r+3]);}
  const float m=max2f(a,b);
  auto rr=__builtin_amdgcn_permlane32_swap(__float_as_uint(m),__float_as_uint(m),false,false);
  return max2f(__uint_as_float(rr[0]),__uint_as_float(rr[1]));
}
__device__ __forceinline__ void pv(f32x16*o,int vb,bf16x8 pa0,bf16x8 pa1,bf16x8 pa2,bf16x8 pa3){
  #pragma unroll
  for(int d0=0;d0<2;++d0){s16x4 lo[4],hi[4];
    #pragma unroll
    for(int ks=0;ks<4;++ks){
      asm volatile("ds_read_b64_tr_b16 %0,%1 offset:%c2":"=&v"(lo[ks]):"v"(vb),"i"(d0*4096+ks*1024):"memory");
      asm volatile("ds_read_b64_tr_b16 %0,%1 offset:%c2":"=&v"(hi[ks]):"v"(vb),"i"(d0*4096+ks*1024+512):"memory");}
    asm volatile("s_waitcnt lgkmcnt(0)":::"memory");SBAR();
    #define PK(k) (bf16x8){lo[k][0],lo[k][1],lo[k][2],lo[k][3],hi[k][0],hi[k][1],hi[k][2],hi[k][3]}
    o[d0]=__builtin_amdgcn_mfma_f32_32x32x16_bf16(pa0,PK(0),o[d0],0,0,0);
    o[d0]=__builtin_amdgcn_mfma_f32_32x32x16_bf16(pa1,PK(1),o[d0],0,0,0);
    o[d0]=__builtin_amdgcn_mfma_f32_32x32x16_bf16(pa2,PK(2),o[d0],0,0,0);
    o[d0]=__builtin_amdgcn_mfma_f32_32x32x16_bf16(pa3,PK(3),o[d0],0,0,0);
    #undef PK
  }
}

#ifndef ATTN_STORE16
#define ATTN_STORE16(p,v) (*(u32x4*)(p)=(v))
#endif
template<int MODE,int THRL,bool FIXR=false> __device__ __forceinline__ void attn_unit(const bf16*__restrict__ QKV,int LD,int qrow0,int qoff,int koff,int voff,int NT,int kbase,const att::MaskP&mk,bf16*Orow0,char*shm,float sink_l2,float mfix_l2=0.f){
  int tid=threadIdx.x; asm volatile("":"+v"(tid));
  const int lane=tid&63,r32=lane&31,hi=lane>>5; const int wid=__builtin_amdgcn_readfirstlane(tid>>6);
  const bf16*Qw=QKV+(size_t)(qrow0+wid*QBLK)*LD+qoff;
  const bf16*Kh=QKV+koff,*Vh=QKV+voff;
  #define K0T(t) ((t)<4?64*(t):kbase+64*((t)-4))
  const unsigned lds0=(unsigned)(uintptr_t)shm;
  float*wsf=(float*)(shm+LDS_WS)+wid*64;
  const bf16*ksrc=Kh+(long)lane*LD+wid*8;
  const bf16*vsrc=Vh+(long)(16*(wid&3)+(lane>>2))*LD+(wid>>2)*32+(lane&3)*8;
  const unsigned kdst=lds0+LDS_K+wid*1024, vdst=lds0+LDS_V+wid*1024;
  #define DMA_K(t,slot) glds16(ksrc+(long)K0T(t)*LD,(unsigned)__builtin_amdgcn_readfirstlane(kdst+(slot)))
  #define DMA_V(t,slot) glds16(vsrc+(long)K0T(t)*LD,(unsigned)__builtin_amdgcn_readfirstlane(vdst+(slot)))
  const int vb0=(int)(lds0+LDS_V)+((lane>>4)&1)*32+(lane&3)*8+(4*hi+((lane&15)>>2))*64;
  const char*Kbase=shm+LDS_K; bf16x8 kf[8];
  const lds_cptr shm3=(lds_cptr)shm; const lds_cptr kp0=shm3+LDS_K+hi*1024+r32*16; const lds_cptr vp0=shm3+LDS_V+((lane>>4)&1)*32+(lane&3)*8+(4*hi+((lane&15)>>2))*64;
  DMA_K(0,0);DMA_V(0,0);DMA_K(1,SLOTB);
  bf16x8 qr[4];
  #pragma unroll
  for(int d0=0;d0<4;++d0)qr[d0]=*reinterpret_cast<const bf16x8*>(&Qw[(long)r32*LD+d0*16+hi*8]);
  float mhat=FIXR?mfix_l2:0.f,l_reg=0.f;f32x16 o[2];o[0]=f32x16{};o[1]=f32x16{};f32x16 negm;
  { float nz_=-mhat; asm volatile("":"+v"(nz_)); _Pragma("unroll") for(int r=0;r<16;++r)negm[r]=nz_; } asm volatile("":"+v"(negm));
  #define CMASK(P0,P1,t) att::apply_mask<MODE>(P0,P1,(t),mk,hi)
  bool resc=false;
  #define START(P0,P1) do{ resc=false; \
    if constexpr(!FIXR){ const float rm=rowmax(P0,P1); const float dl=rm; mhat=fadd_s(mhat,dl); \
      _Pragma("unroll") for(int r=0;r<16;++r){P0[r]=fsub_s(P0[r],dl);P1[r]=fsub_s(P1[r],dl);} \
      _Pragma("unroll") for(int r=0;r<16;++r)negm[r]=-mhat; asm volatile("":"+v"(negm)); } \
    _Pragma("unroll") for(int r=0;r<16;++r)P0[r]=__builtin_amdgcn_exp2f(P0[r]); }while(0)
  #define RESC() do{ if(resc){ asm volatile("s_waitcnt lgkmcnt(0)":::"memory"); \
      _Pragma("unroll") for(int d_=0;d_<2;++d_) _Pragma("unroll") for(int r=0;r<16;++r)o[d_][r]*=wsf[crow(r,hi)]; } }while(0)
  f32x16 pA0,pA1,pB0,pB1;
  int sl_prev=0,sl_cur=0,sl_next=SLOTB;
  #define ROT() do{sl_prev=sl_cur;sl_cur=sl_next;sl_next=(sl_next==(NSLOT-1)*SLOTB)?0:sl_next+SLOTB;}while(0)
  DMA_K(2,2*SLOTB);
  WAIT_BAR(3);
  qkt(pA0,pA1,Kbase,qr,negm,r32,hi);asm volatile("s_nop 15\n\ts_nop 7":"+v"(pA0),"+v"(pA1));CMASK(pA0,pA1,0);
  START(pA0,pA1);
  _Pragma("unroll") for(int r=0;r<16;++r)pA1[r]=__builtin_amdgcn_exp2f(pA1[r]);
  WAIT_BAR(0);
  DMA_K(3,0);DMA_V(1,SLOTB);
  ROT();
  kload8(kf,kp0+sl_cur);
  WAIT_BAR(2);
  s16x4 vlo[8],vhi[8]; u32x4 pw0,pw1,pw2,pw3;
  #define PKW(P,B) cvtpk_s(P[B],P[B+1])
  #define PAF(k) __builtin_bit_cast(bf16x8,pw##k)
  #define VFR(i) (bf16x8){vlo[i][0],vlo[i][1],vlo[i][2],vlo[i][3],vhi[i][0],vhi[i][1],vhi[i][2],vhi[i][3]}
  #define PIN(x) asm volatile("":"+v"(x))
  #define MX3(a,b,c) __builtin_fmaxf(__builtin_fmaxf((a),(b)),(c))
  #define GAPA(MF,A0,A1,A2,A3,W0,W1,PW) do{ MF; sacc+=A0; sacc+=A1; sacc+=A2; sacc+=A3; PIN(sacc); W0; W1; PIN(PW); SBAR(); }while(0)
  #define EX(v) __builtin_amdgcn_exp2f(v)
  #define GAPB(MF,X,B) do{ MF; X[B]=EX(X[B]); X[B+1]=EX(X[B+1]); X[B+2]=EX(X[B+2]); X[B+3]=EX(X[B+3]); PIN(X); SBAR(); }while(0)
  #define VRD(i) do{ vlo[i]=vtr(vp_+(((i)>>2)*4096+((i)&3)*1024)); vhi[i]=vtr(vp_+(((i)>>2)*4096+((i)&3)*1024+512)); }while(0)
  #define KRD(G,j) do{ if(G){ kload2(kf,kp0+sl_next,j); SBAR(); } }while(0)
  #define STEP(C0,C1,P0,P1,t,GK,GV,GL) do{ SBAR(); \
    const lds_cptr vp_=vp0+sl_prev; \
    VRD(0); SBAR(); float sacc=(P0[0]+P0[1]); \
    GAPA(C0=__builtin_amdgcn_mfma_f32_32x32x16_bf16(kf[0],qr[0],negm,0,0,0), P0[2],P0[3],P0[4],P0[5],     pw0[0]=PKW(P0,0), pw0[1]=PKW(P0,2), pw0); \
    VRD(4); SBAR(); GAPA(C1=__builtin_amdgcn_mfma_f32_32x32x16_bf16(kf[1],qr[0],negm,0,0,0), P0[6],P0[7],P0[8],P0[9],     pw0[2]=PKW(P0,4), pw0[3]=PKW(P0,6), pw0); \
    VRD(1); SBAR(); GAPA(C0=__builtin_amdgcn_mfma_f32_32x32x16_bf16(kf[2],qr[1],C0,0,0,0),   P0[10],P0[11],P0[12],P0[13], pw1[0]=PKW(P0,8), pw1[1]=PKW(P0,10), pw1); \
    VRD(5); SBAR(); GAPA(C1=__builtin_amdgcn_mfma_f32_32x32x16_bf16(kf[3],qr[1],C1,0,0,0),   P0[14],P0[15],P1[0],P1[1],   pw1[2]=PKW(P0,12),pw1[3]=PKW(P0,14), pw1); \
    VRD(2); SBAR(); GAPA(C0=__builtin_amdgcn_mfma_f32_32x32x16_bf16(kf[4],qr[2],C0,0,0,0),   P1[2],P1[3],P1[4],P1[5],     pw2[0]=PKW(P1,0), pw2[1]=PKW(P1,2), pw2); \
    VRD(6); SBAR(); GAPA(C1=__builtin_amdgcn_mfma_f32_32x32x16_bf16(kf[5],qr[2],C1,0,0,0),   P1[6],P1[7],P1[8],P1[9],     pw2[2]=PKW(P1,4), pw2[3]=PKW(P1,6), pw2); \
    VRD(3); SBAR(); GAPA(C0=__builtin_amdgcn_mfma_f32_32x32x16_bf16(kf[6],qr[3],C0,0,0,0),   P1[10],P1[11],P1[12],P1[13], pw3[0]=PKW(P1,8), pw3[1]=PKW(P1,10), pw3); \
    VRD(7); SBAR(); GAPA(C1=__builtin_amdgcn_mfma_f32_32x32x16_bf16(kf[7],qr[3],C1,0,0,0),   P1[14],P1[15],0.f,0.f,       pw3[2]=PKW(P1,12),pw3[3]=PKW(P1,14), pw3); \
    l_reg+=sacc; \
    if(GK){DMA_K((t)+3,sl_cur);} if(GV){DMA_V((t)+1,sl_next);} \
    CMASK(C0,C1,t); \
    if constexpr(!FIXR){ float a=MX3(C0[0],C0[1],C1[0]),b=MX3(C0[2],C0[3],C1[1]); a=MX3(a,C1[2],C1[3]); \
      _Pragma("unroll") for(int r=4;r<16;r+=4){a=MX3(a,C0[r],C0[r+1]);b=MX3(b,C0[r+2],C0[r+3]);a=MX3(a,C1[r],C1[r+1]);b=MX3(b,C1[r+2],C1[r+3]);} \
      float rm=__builtin_fmaxf(a,b); { auto rr=__builtin_amdgcn_permlane32_swap(__float_as_uint(rm),__float_as_uint(rm),false,false); rm=__builtin_fmaxf(__uint_as_float(rr[0]),__uint_as_float(rr[1])); } \
      resc=false; \
      if(__builtin_expect(__any(rm>(float)THRL),0)){ const float dl=__builtin_fmaxf(rm,0.f); mhat+=dl; \
        _Pragma("unroll") for(int r=0;r<16;++r){C0[r]-=dl;C1[r]-=dl;} \
        _Pragma("unroll") for(int r=0;r<16;++r)negm[r]=-mhat; asm volatile("":"+v"(negm)); \
        const float f=__builtin_amdgcn_exp2f(-dl); l_reg*=f; if(hi==0)wsf[r32]=f; resc=true; } } \
    SBAR(); \
    GAPB(o[0]=__builtin_amdgcn_mfma_f32_32x32x16_bf16(PAF(0),VFR(0),o[0],0,0,0), C0,0); \
    GAPB(o[1]=__builtin_amdgcn_mfma_f32_32x32x16_bf16(PAF(0),VFR(4),o[1],0,0,0), C0,4); \
    KRD(GL,0); GAPB(o[0]=__builtin_amdgcn_mfma_f32_32x32x16_bf16(PAF(1),VFR(1),o[0],0,0,0), C0,8); \
    KRD(GL,1); GAPB(o[1]=__builtin_amdgcn_mfma_f32_32x32x16_bf16(PAF(1),VFR(5),o[1],0,0,0), C0,12); \
    KRD(GL,2); GAPB(o[0]=__builtin_amdgcn_mfma_f32_32x32x16_bf16(PAF(2),VFR(2),o[0],0,0,0), C1,0); \
    KRD(GL,3); GAPB(o[1]=__builtin_amdgcn_mfma_f32_32x32x16_bf16(PAF(2),VFR(6),o[1],0,0,0), C1,4); \
    GAPB(o[0]=__builtin_amdgcn_mfma_f32_32x32x16_bf16(PAF(3),VFR(3),o[0],0,0,0), C1,8); \
    GAPB(o[1]=__builtin_amdgcn_mfma_f32_32x32x16_bf16(PAF(3),VFR(7),o[1],0,0,0), C1,12); \
    }while(0)
  int t=1;
  for(;t+5<NT;t+=2){
    STEP(pB0,pB1,pA0,pA1,t,true,true,true);     WAIT_BAR(2); RESC(); ROT();
    STEP(pA0,pA1,pB0,pB1,t+1,true,true,true);   WAIT_BAR(2); RESC(); ROT();
  }
  #define ENDW(tt) do{ if((tt)+3<NT){WAIT_BAR(2);} else if((tt)+2<NT){WAIT_BAR(1);} else {WAIT_BAR(0);} }while(0)
  for(;t+1<NT;t+=2){
    STEP(pB0,pB1,pA0,pA1,t,(t+3<NT),(t+1<NT),(t+1<NT));       ENDW(t);   RESC(); ROT();
    STEP(pA0,pA1,pB0,pB1,t+1,(t+4<NT),(t+2<NT),(t+2<NT));     ENDW(t+1); RESC(); ROT();
  }
  STEP(pB0,pB1,pA0,pA1,NT-1,false,false,false); RESC();
  { float sacc=pB0[0]+pB0[1]; _Pragma("unroll") for(int r=2;r<16;++r)sacc+=pB0[r]; _Pragma("unroll") for(int r=0;r<16;++r)sacc+=pB1[r]; l_reg+=sacc;
    pw0=(u32x4){PKW(pB0,0),PKW(pB0,2),PKW(pB0,4),PKW(pB0,6)};pw1=(u32x4){PKW(pB0,8),PKW(pB0,10),PKW(pB0,12),PKW(pB0,14)};pw2=(u32x4){PKW(pB1,0),PKW(pB1,2),PKW(pB1,4),PKW(pB1,6)};pw3=(u32x4){PKW(pB1,8),PKW(pB1,10),PKW(pB1,12),PKW(pB1,14)};
    SBAR(); pv(o,vb0+sl_cur,PAF(0),PAF(1),PAF(2),PAF(3)); }
  #undef PKW
  #undef PAF
  #undef VFR
  #undef PIN
  #undef MX3
  #undef GAPA
  #undef GAPB
  #undef EX
  #undef VRD
  #undef KRD
  #undef STEP
  #undef ENDW
  {auto rr=__builtin_amdgcn_permlane32_swap(__float_as_uint(l_reg),__float_as_uint(l_reg),false,false);l_reg=__uint_as_float(rr[0])+__uint_as_float(rr[1]);}
  if(MODE==1)l_reg+=__builtin_amdgcn_exp2f(sink_l2-mhat);
  if(hi==0)wsf[32+r32]=l_reg;asm volatile("s_waitcnt lgkmcnt(0)":::"memory");
  float rli[16];
  #pragma unroll
  for(int r=0;r<16;++r)rli[r]=__builtin_amdgcn_rcpf(wsf[32+crow(r,hi)]);
  bf16*Ow=Orow0+(size_t)(wid*QBLK)*1024;
  { bf16*stg=(bf16*)(shm+LDS_OST)+wid*2048;
    #pragma unroll
    for(int r=0;r<16;++r){const int orow=crow(r,hi);
      #pragma unroll
      for(int d0=0;d0<2;++d0)stg[orow*64+d0*32+r32]=(bf16)f2bf(o[d0][r]*rli[r]);}
    asm volatile("s_waitcnt lgkmcnt(0)":::"memory");
    #pragma unroll
    for(int i=0;i<4;++i){const int row=i*8+(lane>>3),ch=lane&7; const u32x4 v=*(const u32x4*)(stg+row*64+ch*8); ATTN_STORE16(Ow+(long)row*1024+ch*8,v);} }
  asm volatile("s_waitcnt lgkmcnt(0)\n\ts_barrier":::"memory");
  #undef DMA_K
  #undef DMA_V
  #undef CMASK
  #undef START
  #undef RESC
  #undef ROT
}
#undef K0T

__device__ __forceinline__ void core128h(int tid,const bf16*__restrict__ QKV,int LD,int qrow0,int qoff,int koff,int voff,int NT,int kbase,char*shm,f32x16(&o)[4],float&l_out){
  constexpr int SLOTV=16384, L_K=0, L_V=NSLOT*SLOTB;
  const int lane=tid&63,r32=lane&31,hi=lane>>5; const int wid=__builtin_amdgcn_readfirstlane(tid>>6);
  const bf16*Qw=QKV+(size_t)(qrow0+wid*QBLK)*LD+qoff;
  const bf16*Kh=QKV+koff,*Vh=QKV+voff;
  #define K0T(t) ((t)<4?64*(t):kbase+64*((t)-4))
  const unsigned lds0=(unsigned)(uintptr_t)shm;
  const bf16*ksrc=Kh+(long)lane*LD+wid*8;
  const bf16*vsrc=Vh+(long)(16*(wid&3)+(lane>>2))*LD+(wid>>2)*32+(lane&3)*8;
  const unsigned kdst=lds0+L_K+wid*1024, vdst=lds0+L_V+wid*1024;
  #define DMA_K(t,slot) glds16(ksrc+(long)K0T(t)*LD,(unsigned)__builtin_amdgcn_readfirstlane(kdst+(slot)))
  #define DMA_V(t,slot) do{ glds16(vsrc+(long)K0T(t)*LD,(unsigned)__builtin_amdgcn_readfirstlane(vdst+2*(slot))); glds16(vsrc+(long)K0T(t)*LD+64,(unsigned)__builtin_amdgcn_readfirstlane(vdst+2*(slot)+8192)); }while(0)
  const int vb0=(int)(lds0+L_V)+((lane>>4)&1)*32+(lane&3)*8+(4*hi+((lane&15)>>2))*64;
  const char*Kbase=shm+L_K; bf16x8 kf[8];
  const lds_cptr shm3=(lds_cptr)shm; const lds_cptr kp0=shm3+L_K+hi*1024+r32*16; const lds_cptr vp0=shm3+L_V+((lane>>4)&1)*32+(lane&3)*8+(4*hi+((lane&15)>>2))*64;
  DMA_K(0,0);DMA_V(0,0);DMA_K(1,SLOTB);
  bf16x8 qr[4];
  #pragma unroll
  for(int d0=0;d0<4;++d0){ const bf16x8 raw=*reinterpret_cast<const bf16x8*>(&Qw[(long)r32*LD+d0*16+hi*8]); u32x4 w;
    #pragma unroll
    for(int j=0;j<4;++j)w[j]=cvtpk_s(bf2f((unsigned short)raw[2*j])*C2,bf2f((unsigned short)raw[2*j+1])*C2);
    qr[d0]=__builtin_bit_cast(bf16x8,w); }
  float l_reg=0.f;
  #pragma unroll
  for(int d=0;d<4;++d)o[d]=f32x16{};
  f32x16 pA0,pA1,pB0,pB1;
  int sl_prev=0,sl_cur=0,sl_next=SLOTB;
  #define ROT() do{sl_prev=sl_cur;sl_cur=sl_next;sl_next=(sl_next==(NSLOT-1)*SLOTB)?0:sl_next+SLOTB;}while(0)
  DMA_K(2,2*SLOTB);
  WAIT_BAR(4);
  { const f32x16 zz=f32x16{}; qkt(pA0,pA1,Kbase,qr,zz,r32,hi); } asm volatile("s_nop 15\n\ts_nop 7":"+v"(pA0),"+v"(pA1));
  _Pragma("unroll") for(int r=0;r<16;++r)pA0[r]=__builtin_amdgcn_exp2f(pA0[r]);
  _Pragma("unroll") for(int r=0;r<16;++r)pA1[r]=__builtin_amdgcn_exp2f(pA1[r]);
  WAIT_BAR(0);
  DMA_K(3,0);DMA_V(1,SLOTB);
  ROT();
  kload8(kf,kp0+sl_cur);
  WAIT_BAR(3);
  s16x4 vlo[4],vhi[4]; u32x4 pw0,pw1,pw2,pw3;
  #define PKW(P,B) cvtpk_s(P[B],P[B+1])
  #define PAF(k) __builtin_bit_cast(bf16x8,pw##k)
  #define VFRN(n) (bf16x8){vlo[(n)&3][0],vlo[(n)&3][1],vlo[(n)&3][2],vlo[(n)&3][3],vhi[(n)&3][0],vhi[(n)&3][1],vhi[(n)&3][2],vhi[(n)&3][3]}
  #define PIN(x) asm volatile("":"+v"(x))
  #define GAPA(MF,A0,A1,A2,A3,W0,W1,PW) do{ MF; sacc+=A0; sacc+=A1; sacc+=A2; sacc+=A3; PIN(sacc); W0; W1; PIN(PW); SBAR(); }while(0)
  #define EX(v) __builtin_amdgcn_exp2f(v)
  #define GAPB2(MF,X,B) do{ MF; X[B]=EX(X[B]); X[B+1]=EX(X[B+1]); PIN(X); SBAR(); }while(0)
  #define VRDN(n) do{ vlo[(n)&3]=vtr(vp_+(((n)&3)*4096+((n)>>2)*1024)); vhi[(n)&3]=vtr(vp_+(((n)&3)*4096+((n)>>2)*1024+512)); SBAR(); }while(0)
  #define KRD(G,j) do{ if(G){ kload2(kf,kp0+sl_next,j); SBAR(); } }while(0)
  #define PVN(n,k,X,B) GAPB2(o[(n)&3]=__builtin_amdgcn_mfma_f32_32x32x16_bf16(PAF(k),VFRN(n),o[(n)&3],0,0,0), X,B)
  #define STEP(C0,C1,P0,P1,t,GK,GV,GL) do{ SBAR(); \
    const lds_cptr vp_=vp0+2*sl_prev; \
    VRDN(0); float sacc=(P0[0]+P0[1]); \
    GAPA(C0=__builtin_amdgcn_mfma_f32_32x32x16_bf16(kf[0],qr[0],f32x16{},0,0,0), P0[2],P0[3],P0[4],P0[5],     pw0[0]=PKW(P0,0), pw0[1]=PKW(P0,2), pw0); \
    GAPA(C1=__builtin_amdgcn_mfma_f32_32x32x16_bf16(kf[1],qr[0],f32x16{},0,0,0), P0[6],P0[7],P0[8],P0[9],     pw0[2]=PKW(P0,4), pw0[3]=PKW(P0,6), pw0); \
    VRDN(1); GAPA(C0=__builtin_amdgcn_mfma_f32_32x32x16_bf16(kf[2],qr[1],C0,0,0,0),   P0[10],P0[11],P0[12],P0[13], pw1[0]=PKW(P0,8), pw1[1]=PKW(P0,10), pw1); \
    GAPA(C1=__builtin_amdgcn_mfma_f32_32x32x16_bf16(kf[3],qr[1],C1,0,0,0),   P0[14],P0[15],P1[0],P1[1],   pw1[2]=PKW(P0,12),pw1[3]=PKW(P0,14), pw1); \
    VRDN(2); GAPA(C0=__builtin_amdgcn_mfma_f32_32x32x16_bf16(kf[4],qr[2],C0,0,0,0),   P1[2],P1[3],P1[4],P1[5],     pw2[0]=PKW(P1,0), pw2[1]=PKW(P1,2), pw2); \
    GAPA(C1=__builtin_amdgcn_mfma_f32_32x32x16_bf16(kf[5],qr[2],C1,0,0,0),   P1[6],P1[7],P1[8],P1[9],     pw2[2]=PKW(P1,4), pw2[3]=PKW(P1,6), pw2); \
    VRDN(3); GAPA(C0=__builtin_amdgcn_mfma_f32_32x32x16_bf16(kf[6],qr[3],C0,0,0,0),   P1[10],P1[11],P1[12],P1[13], pw3[0]=PKW(P1,8), pw3[1]=PKW(P1,10), pw3); \
    GAPA(C1=__builtin_amdgcn_mfma_f32_32x32x16_bf16(kf[7],qr[3],C1,0,0,0),   P1[14],P1[15],0.f,0.f,       pw3[2]=PKW(P1,12),pw3[3]=PKW(P1,14), pw3); \
    l_reg+=sacc; \
    if(GK){DMA_K((t)+3,sl_cur);} if(GV){DMA_V((t)+1,sl_next);} \
    SBAR(); \
    PVN(0,0,C0,0);  VRDN(4);  PVN(1,0,C0,2);  VRDN(5);  PVN(2,0,C0,4);  VRDN(6);  PVN(3,0,C0,6);  VRDN(7); \
    PVN(4,1,C0,8);  VRDN(8);  PVN(5,1,C0,10); VRDN(9);  PVN(6,1,C0,12); VRDN(10); PVN(7,1,C0,14); VRDN(11); \
    PVN(8,2,C1,0);  VRDN(12); PVN(9,2,C1,2);  VRDN(13); KRD(GL,0); PVN(10,2,C1,4); VRDN(14); KRD(GL,1); PVN(11,2,C1,6); VRDN(15); \
    KRD(GL,2); PVN(12,3,C1,8); KRD(GL,3); PVN(13,3,C1,10); PVN(14,3,C1,12); PVN(15,3,C1,14); \
    }while(0)
  int t=1;
  for(;t+5<NT;t+=2){
    STEP(pB0,pB1,pA0,pA1,t,true,true,true);     WAIT_BAR(3); ROT();
    STEP(pA0,pA1,pB0,pB1,t+1,true,true,true);   WAIT_BAR(3); ROT();
  }
  #define ENDW(tt) do{ if((tt)+3<NT){WAIT_BAR(3);} else if((tt)+2<NT){WAIT_BAR(2);} else {WAIT_BAR(0);} }while(0)
  for(;t+1<NT;t+=2){
    STEP(pB0,pB1,pA0,pA1,t,(t+3<NT),(t+1<NT),(t+1<NT));       ENDW(t);   ROT();
    STEP(pA0,pA1,pB0,pB1,t+1,(t+4<NT),(t+2<NT),(t+2<NT));     ENDW(t+1); ROT();
  }
  STEP(pB0,pB1,pA0,pA1,NT-1,false,false,false);
  { float sacc=pB0[0]+pB0[1]; _Pragma("unroll") for(int r=2;r<16;++r)sacc+=pB0[r]; _Pragma("unroll") for(int r=0;r<16;++r)sacc+=pB1[r]; l_reg+=sacc;
    pw0=(u32x4){PKW(pB0,0),PKW(pB0,2),PKW(pB0,4),PKW(pB0,6)};pw1=(u32x4){PKW(pB0,8),PKW(pB0,10),PKW(pB0,12),PKW(pB0,14)};pw2=(u32x4){PKW(pB1,0),PKW(pB1,2),PKW(pB1,4),PKW(pB1,6)};pw3=(u32x4){PKW(pB1,8),PKW(pB1,10),PKW(pB1,12),PKW(pB1,14)};
    SBAR(); pv(o,vb0+2*sl_cur,PAF(0),PAF(1),PAF(2),PAF(3)); pv(o+2,vb0+2*sl_cur+8192,PAF(0),PAF(1),PAF(2),PAF(3)); }
  #undef PKW
  #undef PAF
  #undef VFRN
  #undef PIN
  #undef GAPA
  #undef GAPB2
  #undef EX
  #undef VRDN
  #undef PVN
  #undef KRD
  #undef STEP
  #undef ENDW
  {auto rr=__builtin_amdgcn_permlane32_swap(__float_as_uint(l_reg),__float_as_uint(l_reg),false,false);l_reg=__uint_as_float(rr[0])+__uint_as_float(rr[1]);}
  l_out=l_reg;
  asm volatile("s_waitcnt lgkmcnt(0)\n\ts_barrier":::"memory");
  #undef DMA_K
  #undef DMA_V
  #undef ROT
  #undef K0T
}
#undef SBAR
#undef WAIT_BAR
}


#define GAS __attribute__((address_space(1)))
#define LAS __attribute__((address_space(3)))
#define XB_TMO      128
#define XB_XCNT(j)  (256  + 64 * (j))
#define XB_XSUB(j)  (1280 + 64 * (j))
#define XB_XGEN(j)  (2304 + 64 * (j))
#define XB_TOP      3328
#define XB_TOPGEN   3392
#define XCD_BAR_WORDS 3456
#define XB_SPIN_CAP (1u << 18)
__device__ __forceinline__ unsigned xb_ld(unsigned* p)              { return __hip_atomic_load(p, __ATOMIC_RELAXED, __HIP_MEMORY_SCOPE_AGENT); }
__device__ __forceinline__ unsigned xb_add(unsigned* p, unsigned v) { return __hip_atomic_fetch_add(p, v, __ATOMIC_RELAXED, __HIP_MEMORY_SCOPE_AGENT); }
__device__ __forceinline__ unsigned xb_xcc_id() { return (unsigned)__builtin_amdgcn_s_getreg((3 << 11) | 20) & 0xFu; }
#define XB_SPIN(cond, bar) do { unsigned _sp = 0; while (cond) { __builtin_amdgcn_s_sleep(1); \
    if ((++_sp & 255u) == 0u) { if (xb_ld(&(bar)[XB_TMO])) break; if (_sp > XB_SPIN_CAP) { atomicAdd(&(bar)[XB_TMO], 1u); break; } } } } while (0)
struct XcdBarrier { unsigned* bar; unsigned x; volatile LAS unsigned* st; };
__device__ __forceinline__ XcdBarrier xcd_barrier_post(unsigned* bar, volatile LAS unsigned* st) {
    XcdBarrier b; b.bar = bar; b.x = xb_xcc_id(); b.st = st;
    if (threadIdx.x == 0) (void)xb_add(&bar[XB_XCNT(b.x)], 1u);
    return b;
}
__device__ __forceinline__ void xcd_barrier_complete(unsigned* bar, unsigned x, unsigned& nloc, unsigned& nx) {
    const unsigned G = gridDim.x * gridDim.y * gridDim.z;
    unsigned sum, cnt, mine, sp = 0u;
    for (;;) {
        sum = 0u; cnt = 0u; mine = 0u;
#pragma unroll
        for (unsigned j = 0; j < 16; ++j) { const unsigned c = xb_ld(&bar[XB_XCNT(j)]); sum += c; cnt += (c > 0u) ? 1u : 0u; mine = (j == x) ? c : mine; }
        if (sum == G) break;
        __builtin_amdgcn_s_sleep(1);
        if ((++sp & 255u) == 0u) { if (xb_ld(&bar[XB_TMO])) break; if (sp > XB_SPIN_CAP) { atomicAdd(&bar[XB_TMO], 1u); break; } }
    }
    nloc = mine > 0u ? mine : 1u; nx = cnt > 0u ? cnt : 1u;
}
__device__ __forceinline__ void xcd_barrier(const XcdBarrier& b) {
    asm volatile("s_waitcnt vmcnt(0)" ::: "memory");
    __syncthreads();
    if (threadIdx.x == 0) {
        unsigned* bar = b.bar;
        __builtin_amdgcn_s_waitcnt(0);
        unsigned nloc = b.st[0], nx = b.st[1];
        if (nloc == 0u) { xcd_barrier_complete(bar, b.x, nloc, nx); b.st[0] = nloc; b.st[1] = nx; }
        const unsigned old = xb_add(&bar[XB_XSUB(b.x)], 1u);
        const unsigned gen = old / nloc;
        if (old + 1u == (gen + 1u) * nloc) {
            __builtin_amdgcn_fence(__ATOMIC_RELEASE, "agent");
            asm volatile("s_waitcnt vmcnt(0)" ::: "memory");
            const unsigned og = xb_add(&bar[XB_TOP], 1u);
            const unsigned tgt = (og / nx + 1u) * nx;
            if (og + 1u != tgt) XB_SPIN((int)(xb_ld(&bar[XB_TOP]) - tgt) < 0, bar);
            __builtin_amdgcn_fence(__ATOMIC_ACQUIRE, "agent");
            asm volatile("s_waitcnt vmcnt(0)" ::: "memory");
        } else {
            const unsigned tgt = (gen + 1u) * nx;
            XB_SPIN((int)(xb_ld(&bar[XB_TOP]) - tgt) < 0, bar);
            __builtin_amdgcn_fence(__ATOMIC_ACQUIRE, "agent");
            asm volatile("s_waitcnt vmcnt(0)" ::: "memory");
        }
    }
    __syncthreads();
}

__device__ __forceinline__ void p0_transpose_item(const float* W, int K, int N, bf16* WT, int mode, float* scr, int item, int lane) {
    const int nblk = N / 32, kb = item / nblk, nb = item % nblk, k0 = 64 * kb, n0 = 32 * nb;
#pragma unroll 8
    for (int i = 0; i < 32; ++i) { const int kk = 2 * i + (lane >> 5); scr[kk * 33 + (lane & 31)] = W[(size_t)(k0 + kk) * N + n0 + (lane & 31)]; }
    asm volatile("s_waitcnt lgkmcnt(0)" ::: "memory");
    const int c = lane & 7;
#pragma unroll
    for (int j = 0; j < 4; ++j) { const int n = (lane >> 3) + 8 * j; const float* s = scr + (8 * c) * 33 + n;
        u32x4 o; o.x = pk2(s[0 * 33], s[1 * 33]); o.y = pk2(s[2 * 33], s[3 * 33]); o.z = pk2(s[4 * 33], s[5 * 33]); o.w = pk2(s[6 * 33], s[7 * 33]);
        const int drow = mode == 0 ? n0 + n : 2 * n0 + (n < 16 ? n : n + 16) + (mode == 2 ? 16 : 0);
        *(u32x4*)(WT + (size_t)drow * K + k0 + 8 * c) = o; }
    asm volatile("s_waitcnt lgkmcnt(0)" ::: "memory");
}
constexpr size_t WQKV_OFF[4] = {0, (size_t)3072 * 1024, (size_t)(3072 + 1536) * 1024, (size_t)(3072 + 1536 + 1536) * 1024};
__device__ __forceinline__ bool tail_rank(int nwg, int G, int c, int& rank, int& nranks) {
    const int rem = nwg % G;
    if (rem == 0) { rank = c; nranks = G; return true; }
    if (c < rem) return false;
    rank = c - rem; nranks = G - rem; return true;
}
template <int L> __device__ __forceinline__ void conv_proj(const P& p, unsigned char* lds, int rank, int nranks) {
    constexpr int NQKV = (L == 0 || L == 3) ? 3072 : 1536, NQ = 16 * (NQKV / 32);
    constexpr int IQ = L == 0 ? I_AQKV : L == 1 ? I_BQKV : L == 2 ? I_CQKV : I_DQKV, IO = L == 0 ? I_AWO : L == 1 ? I_BWO : L == 2 ? I_CWO : I_DWO;
    const int wave = threadIdx.x >> 6, lane = threadIdx.x & 63;
    float* scr = (float*)(lds + 16384 + wave * 12288);
    bf16* WQ = (bf16*)(p.ws + WS_WQKV) + WQKV_OFF[L]; bf16* WO = (bf16*)(p.ws + WS_WO) + (size_t)L * 1024 * 1024;
    for (int it = rank * 8 + wave; it < NQ + 512; it += nranks * 8) {
        if (it < NQ) p0_transpose_item(p.in[IQ], 1024, NQKV, WQ, 0, scr, it, lane);
        else p0_transpose_item(p.in[IO], 1024, 1024, WO, 0, scr, it - NQ, lane);
    }
}
constexpr int MOE_ITEMS = 3 * 8192;
template <int L> __device__ __forceinline__ void conv_moe(const P& p, unsigned char* lds, int v0, int v1, int rank, int nranks) {
    const int wave = threadIdx.x >> 6, lane = threadIdx.x & 63;
    float* scr = (float*)(lds + 16384 + wave * 12288);
    bf16* WG = (bf16*)(p.ws + WS_WG); bf16* WD = (bf16*)(p.ws + WS_WD);
    for (int v = v0 + rank * 8 + wave; v < v1; v += nranks * 8) {
        const int kind = v >> 13, r = v & 8191, le = L * 32 + (r >> 8), sub = r & 255;
        if (kind == 0) p0_transpose_item(p.in[I_WGATE] + (size_t)le * 1024 * 512, 1024, 512, WG + (size_t)le * 1024 * 1024, 1, scr, sub, lane);
        else if (kind == 1) p0_transpose_item(p.in[I_WUP] + (size_t)le * 1024 * 512, 1024, 512, WG + (size_t)le * 1024 * 1024, 2, scr, sub, lane);
        else p0_transpose_item(p.in[I_WDOWN] + (size_t)le * 512 * 1024, 512, 1024, WD + (size_t)le * 1024 * 512, 0, scr, sub, lane);
    }
}
constexpr int MV_A = 8576;
constexpr int MV3_B = 13488, MV3_C = 17176;
template <int L, int KIND> __device__ __forceinline__ void tail_conv(const P& p, unsigned char* lds, int rank, int nranks) {
    if constexpr (L == 0 && KIND == 0) conv_moe<0>(p, lds, 0, 7800, rank, nranks);
    if constexpr (L == 0 && KIND == 1) conv_moe<0>(p, lds, 7800, 20296, rank, nranks);
    if constexpr (L == 0 && KIND == 2) { conv_moe<0>(p, lds, 20296, MOE_ITEMS, rank, nranks); conv_proj<1>(p, lds, rank, nranks); conv_moe<1>(p, lds, 0, 4400, rank, nranks); }
    if constexpr (L == 0 && KIND == 3) conv_moe<1>(p, lds, 4400, 9400, rank, nranks);
    if constexpr (L == 1 && KIND == 0) conv_moe<1>(p, lds, 9400, 17200, rank, nranks);
    if constexpr (L == 1 && KIND == 1) { conv_moe<1>(p, lds, 17200, MOE_ITEMS, rank, nranks); conv_proj<2>(p, lds, rank, nranks); conv_moe<2>(p, lds, 0, 3800, rank, nranks); }
    if constexpr (L == 1 && KIND == 2) conv_moe<2>(p, lds, 3800, 13800, rank, nranks);
    if constexpr (L == 1 && KIND == 3) conv_moe<2>(p, lds, 13800, 18800, rank, nranks);
    if constexpr (L == 2 && KIND == 0) { conv_moe<2>(p, lds, 18800, MOE_ITEMS, rank, nranks); conv_proj<3>(p, lds, rank, nranks); }
    if constexpr (L == 2 && KIND == 1) conv_moe<3>(p, lds, 0, 12504, rank, nranks);
    if constexpr (L == 2 && KIND == 2) conv_moe<3>(p, lds, 12504, 22504, rank, nranks);
    if constexpr (L == 2 && KIND == 3) conv_moe<3>(p, lds, 22504, MOE_ITEMS, rank, nranks);
}
__device__ __forceinline__ void ph_weights(const P& p, unsigned char* lds) {
    { float* wrt = (float*)(p.ws + WS_WRT);
      for (int i = blockIdx.x * 512 + threadIdx.x; i < 4 * 36 * 1024; i += gridDim.x * 512) { const int l = i / (36 * 1024), r = i % (36 * 1024), n = r >> 10, k = r & 1023;
          wrt[i] = n < 4 ? p.in[I_RG][(size_t)l * 4096 + k * 4 + n] : p.in[I_RE][(size_t)l * 32768 + k * 32 + n - 4]; } }
    conv_proj<0>(p, lds, (int)blockIdx.x, (int)gridDim.x);
}

#define MK_LDS3(l) ((PG8_LAS unsigned char*)(l))
template <int L> __device__ __forceinline__ void ph_qkv(const P& p, unsigned char* lds) {
    constexpr int NQKV = (L == 0 || L == 3) ? 3072 : 1536;
    pg8::Gemm g{(const bf16*)(p.ws + WS_H), (const bf16*)(p.ws + WS_WQKV) + WQKV_OFF[L], T, NQKV, 1024};
    pg8::StaticOrder S; S.init(T, NQKV, (int)gridDim.x, (int)blockIdx.x);
    if constexpr (L == 0 || L == 1) { pg8::EpiRopeBf16 E{(bf16*)(p.ws + WS_QKV), NQKV, (const float*)(p.ws + WS_ROPE), L == 1 ? 5 : 8, L == 1 ? 4 : 0, L == 1 ? 0.125f * 1.4426950408889634f : 1.f};
        int rank, nranks; const bool tail = tail_rank((T / 256) * (NQKV / 256), (int)gridDim.x, (int)blockIdx.x, rank, nranks), first = tail && (rank & 1);
        if (first) { tail_conv<L, 0>(p, lds, rank, nranks); __syncthreads(); }
        pg8::gemm_phase<pg8::EpiRopeBf16, pg8::StaticOrder, true, true>(MK_LDS3(lds), g, S, E);
        if (tail && !first) tail_conv<L, 0>(p, lds, rank, nranks);
        return; }
    pg8::EpiBf16 E{(bf16*)(p.ws + WS_QKV), NQKV, L == 3 ? 4 : 0, 0.125f * 1.4426950408889634f};
    int rank, nranks; const bool tail = tail_rank((T / 256) * (NQKV / 256), (int)gridDim.x, (int)blockIdx.x, rank, nranks), first = tail && L < 3 && (rank & 1);
    if (first) { tail_conv<L, 0>(p, lds, rank, nranks); __syncthreads(); }
    pg8::gemm_phase<pg8::EpiBf16, pg8::StaticOrder, true, true>(MK_LDS3(lds), g, S, E);
    if (tail && !first) tail_conv<L, 0>(p, lds, rank, nranks);
}
template <int L> __device__ __forceinline__ void ph_wo(const P& p, unsigned char* lds) {
    constexpr int ROFF = L == 3 ? CTX : 0, M = T - ROFF;
    const float* modv = (const float*)(p.ws + WS_MODV);
    pg8::Gemm g{(const bf16*)(p.ws + WS_O) + (size_t)ROFF * 1024, (const bf16*)(p.ws + WS_WO) + (size_t)L * 1024 * 1024, M, 1024, 1024};
    pg8::StaticOrder S; S.init(M, 1024, (int)gridDim.x, (int)blockIdx.x);
    pg8::EpiResid E{(pg8::bf16_t*)(p.ws + WS_X), modv + (size_t)(L * 2) * 6144 + 2048, modv + (size_t)(L * 2 + 1) * 6144 + 2048, ROFF};
    int rank, nranks; const bool tail = tail_rank((M / 256) * 4, (int)gridDim.x, (int)blockIdx.x, rank, nranks);
    const bool first = tail && L < 3 && (rank & 1);
    if (first) { tail_conv<L, 1>(p, lds, rank, nranks); __syncthreads(); }
    pg8::gemm_phase<pg8::EpiResid, pg8::StaticOrder, true, true>(MK_LDS3(lds), g, S, E);
    if (tail && !first) tail_conv<L, 1>(p, lds, rank, nranks);
}
template <int L> __device__ __forceinline__ int moe_tiles(const P& p, unsigned char* lds) {
    int* ps = (int*)(lds + MISC_OFF + 64); unsigned char* t2e = lds + MISC_OFF + 512; int* ce = (int*)(lds + MISC_OFF + 768);
    __syncthreads();
    const int* gcnt = (const int*)(p.ws + WS_CTL) + CW_CNT + L * 32;
    if (threadIdx.x < 32) ce[threadIdx.x] = gcnt[threadIdx.x];
    moe_prefix(gcnt, ps);
    const int nt = ps[32] >> 8;
    for (int rt = threadIdx.x; rt < nt; rt += 512) { int e = 0; while (e < 31 && ps[e + 1] <= rt * 256) ++e; t2e[rt] = (unsigned char)e; }
    __syncthreads();
    return nt;
}
template <int L> __device__ __forceinline__ void ph_moe1(const P& p, unsigned char* lds) {
    const int nt = moe_tiles<L>(p, lds);
    pg8::Gemm g{(const bf16*)(p.ws + WS_H), (const bf16*)(p.ws + WS_WG) + (size_t)L * 32 * 1024 * 1024, nt * 256, 1024, 1024};
    pg8::MoeOrder<true> S{(const PG8_LAS unsigned char*)(lds + MISC_OFF + 512), nt, 4, (int)gridDim.x, (int)blockIdx.x, (const int*)(p.ws + WS_LIST), (const PG8_LAS int*)(lds + MISC_OFF + 64), (const PG8_LAS int*)(lds + MISC_OFF + 768), LCAP};
    pg8::EpiSilu E{(bf16*)(p.ws + WS_HID)};
    int rank = 0, nranks = 1; const bool tail = L < 3 && tail_rank(nt * 4, (int)gridDim.x, (int)blockIdx.x, rank, nranks), first = tail && (rank & 1);
    if constexpr (L < 3) { if (first) { tail_conv<L, 2>(p, lds, rank, nranks); __syncthreads(); } }
    pg8::gemm_phase<pg8::EpiSilu, pg8::MoeOrder<true>, true, true>(MK_LDS3(lds), g, S, E);
    if constexpr (L < 3) { if (tail && !first) tail_conv<L, 2>(p, lds, rank, nranks); }
}
template <int L> __device__ __forceinline__ void ph_moe2(const P& p, unsigned char* lds, bool reuse) {
    const int nt = reuse ? (((const int*)(lds + MISC_OFF + 64))[32] >> 8) : moe_tiles<L>(p, lds);
    pg8::Gemm g{(const bf16*)(p.ws + WS_HID), (const bf16*)(p.ws + WS_WD) + (size_t)L * 32 * 1024 * 512, nt * 256, 1024, 512};
    pg8::MoeOrder<false> S{(const PG8_LAS unsigned char*)(lds + MISC_OFF + 512), nt, 4, (int)gridDim.x, (int)blockIdx.x, nullptr, nullptr, nullptr, 0};
    pg8::EpiBf16 E{(bf16*)(p.ws + WS_YB), 1024};
    int rank = 0, nranks = 1; const bool tail = L < 3 && tail_rank(nt * 4, (int)gridDim.x, (int)blockIdx.x, rank, nranks), first = tail && (rank & 1);
    if constexpr (L < 3) { if (first) { tail_conv<L, 3>(p, lds, rank, nranks); __syncthreads(); } }
    pg8::gemm_phase<pg8::EpiBf16, pg8::MoeOrder<false>, true, true>(MK_LDS3(lds), g, S, E);
    if constexpr (L < 3) { if (tail && !first) tail_conv<L, 3>(p, lds, rank, nranks); }
}

template <int FX> __device__ __forceinline__ void diff_units(const P& p, char* lds) {
    using namespace att;
    const bf16* QKV = (const bf16*)(p.ws + WS_QKV); bf16* O = (bf16*)(p.ws + WS_O);
    const float lam = ((const float*)(p.ws + WS_LAM))[0]; const float* sg = p.in[I_ASUB]; const unsigned* qkmax = (const unsigned*)(p.ws + WS_CTL) + CW_QKMAX;
    MaskP mk{};
    for (int u = blockIdx.x; u < 8 * 64 + 8; u += gridDim.x) {
        const bool big = u < 512; const int h = big ? (u & 7) : u - 512, qrow0 = big ? CTX + 256 * (u >> 3) : 0, NT = big ? T / 64 : 4;
        int tidl = threadIdx.x; asm volatile("" : "+v"(tidl));
        const int wid = tidl >> 6, lane = tidl & 63, r32 = lane & 31, hi = lane >> 5;
        f32x16 o[4]; float l, m, rl[16];
#pragma unroll
        for (int sub = 0; sub < 2; ++sub) {
            const int sh_ = 2 * h + sub;
            const float kmaxn = FX ? sqrtf(__uint_as_float(qkmax[16 + sh_])) : 0.f;
            if constexpr (FX == 2) att64::core128h(tidl, QKV, 3072, qrow0, sh_ * 64, 1024 + sh_ * 64, 2048 + h * 128, NT, CTX, lds, o, l);
            else attn_core2<128, 0, FX>(QKV, 3072, qrow0, sh_ * 64, 1024 + sh_ * 64, 2048 + h * 128, NT, CTX, mk, lds, o, l, m, kmaxn);
            bcast_rows(l, rl, lds + Lds2<128>::WSF, wid, r32, hi);
            bf16* stg = (bf16*)(lds + Lds2<128>::STG) + wid * 32 * 128 + (4 * hi) * 128 + r32;
            if (sub == 0) {
#pragma unroll
                for (int r = 0; r < 16; ++r) { const float inv = 1.0f / rl[r];
#pragma unroll
                    for (int d0 = 0; d0 < 4; ++d0) stg[((r & 3) + 8 * (r >> 2)) * 128 + d0 * 32] = (bf16)f2bf(o[d0][r] * inv); }
            } else {
                float sgv[4];
#pragma unroll
                for (int d0 = 0; d0 < 4; ++d0) sgv[d0] = sg[d0 * 32 + r32] * 0.8f;
#pragma unroll
                for (int r = 0; r < 16; ++r) { const float inv = lam / rl[r]; float ss = 0.f;
#pragma unroll
                    for (int d0 = 0; d0 < 4; ++d0) { const float c = bf2f(stg[((r & 3) + 8 * (r >> 2)) * 128 + d0 * 32]) - o[d0][r] * inv; o[d0][r] = c; ss += c * c; }
                    ss += __shfl_xor(ss, 1); ss += __shfl_xor(ss, 2); ss += __shfl_xor(ss, 4); ss += __shfl_xor(ss, 8); ss += __shfl_xor(ss, 16);
                    const float rn = 1.0f / sqrtf(ss * (1.f / 128.f) + EPS);
#pragma unroll
                    for (int d0 = 0; d0 < 4; ++d0) o[d0][r] = o[d0][r] * rn * sgv[d0];
                    asm volatile("" ::: "memory"); }
            }
        }
        store_tile<128>(o, O + (size_t)(qrow0 + wid * 32) * 1024 + h * 128, lds, wid, lane);
    }
}
template <int L> __device__ __forceinline__ void ph_attn(const P& p, unsigned char* lds_) {
    using namespace att;
    char* lds = (char*)lds_;
    const int tid = threadIdx.x, wid = tid >> 6, lane = tid & 63, r32 = lane & 31, hi = lane >> 5;
    const bf16* QKV = (const bf16*)(p.ws + WS_QKV); bf16* O = (bf16*)(p.ws + WS_O);
    MaskP mk{};
    if constexpr (L == 0) {
        const unsigned* qkmax = (const unsigned*)(p.ws + WS_CTL) + CW_QKMAX;
        float gb = 0.f;
        { const int i = lane & 15; gb = wave_max(sqrtf(__uint_as_float(qkmax[i])) * sqrtf(__uint_as_float(qkmax[16 + i]))) * (0.125f * 1.01f); }
        if (gb <= 60.f) diff_units<2>(p, lds); else diff_units<0>(p, lds);
    } else {
        constexpr int MODE = L == 1 ? 1 : L == 3 ? 2 : 0, LD = L == 3 ? 3072 : 1536;
        constexpr int NBIG = 16 * 64, NU = L == 3 ? NBIG : NBIG + 16;
        float* bias_l = (float*)(lds + att64::LDS_BIAS); mk.bias_l = bias_l;
        float mfix = 1e30f;
        if (L == 2) { const float* gq = p.in[I_CQKN]; const float gqm = wave_max(fabsf(gq[lane])), gkm = wave_max(fabsf(gq[64 + lane])); mfix = 8.0f * gqm * gkm * 1.001f; }
        for (int u = blockIdx.x; u < NU; u += gridDim.x) {
            int tidl = threadIdx.x; asm volatile("" : "+v"(tidl));
            const int wid = __builtin_amdgcn_readfirstlane(tidl >> 6), r32 = tidl & 31;
            const bool big = u < NBIG; const int h = big ? (u & 15) : u - NBIG, qbl = u >> 4, qrow0 = big ? CTX + 256 * qbl : 0;
            const int qoff = h * 64, koff = L == 3 ? 1024 + h * 64 : 1024 + (h >> 2) * 64, voff = L == 3 ? 2048 + h * 64 : 1280 + (h >> 2) * 64;
            int NT = big ? T / 64 : 4, kbase = CTX;
            if (L == 1 && big) { const int q0l = 256 * qbl, lo = max(q0l - 128, 0), hi_ = min(q0l + 384, SEQ); NT = 4 + (hi_ - lo) / 64; kbase = CTX + lo; mk.qpos = q0l + wid * 32 + r32; mk.kpos0 = lo; }
            if (L == 3) { const int rlo = min(max(4 * qbl - 4, 0), 248), rhi = min(max(4 * qbl - 1, 0), 248) + 7; int cnt = rhi - rlo + 1; cnt += cnt & 1; NT = 4 + cnt; kbase = CTX + 64 * rlo;
                mk.rb = rlo; mk.qr = 4 * qbl + (wid >> 1); mk.qc = (wid & 1) * 32 + r32; mk.r0 = min(max(mk.qr - 4, 0), 248); mk.c0 = min(max(mk.qc - 8, 0), 48);
                if (tid < 465) bias_l[tid] = p.in[I_DRPB][h * 465 + tid] * LOG2E; }
            if constexpr (L == 3) { att64::attn_unit<2, 8>(QKV, LD, qrow0, qoff, koff, voff, NT, kbase, mk, O + (size_t)qrow0 * 1024 + h * 64, lds, 0.f); continue; }
            if constexpr (L == 1) { att64::attn_unit<1, 8>(QKV, LD, qrow0, qoff, koff, voff, NT, kbase, mk, O + (size_t)qrow0 * 1024 + h * 64, lds, p.in[I_BSINK][h] * LOG2E); continue; }
            if constexpr (L == 2) {
                if (mfix <= 40.f) att64::attn_unit<0, 8, true>(QKV, LD, qrow0, qoff, koff, voff, NT, kbase, mk, O + (size_t)qrow0 * 1024 + h * 64, lds, 0.f, mfix * LOG2E);
                else att64::attn_unit<0, 8>(QKV, LD, qrow0, qoff, koff, voff, NT, kbase, mk, O + (size_t)qrow0 * 1024 + h * 64, lds, 0.f);
                continue; }
            f32x16 o[2]; float l, m, rl[16];
            if (L == 2 && mfix <= 40.f) attn_core2<64, MODE, 1>(QKV, LD, qrow0, qoff, koff, voff, NT, kbase, mk, lds, o, l, m, mfix);
            else attn_core2<64, MODE>(QKV, LD, qrow0, qoff, koff, voff, NT, kbase, mk, lds, o, l, m);
            if (L == 1) l += __builtin_amdgcn_exp2f(p.in[I_BSINK][h] * LOG2E - m * C);
            bcast_rows(l, rl, lds + Lds2<64>::WSF, wid, r32, hi);
#pragma unroll
            for (int r = 0; r < 16; ++r) { const float inv = 1.0f / rl[r]; o[0][r] *= inv; o[1][r] *= inv; }
            store_tile<64>(o, O + (size_t)(qrow0 + wid * 32) * 1024 + h * 64, lds, wid, lane);
        }
    }
}

struct Args { P p; int ph_lo, ph_hi, li, pad; };
constexpr int NPHASE = 38;
typedef const Args __attribute__((address_space(4)))* KArgs;
__device__ __forceinline__ P load_p(KArgs ka) { P p;
#if defined(__HIP_DEVICE_COMPILE__)
    asm volatile("" : "+s"(ka));
#pragma unroll
    for (int i = 0; i < 29; ++i) p.in[i] = ka->p.in[i];
    p.out = ka->p.out; p.ws = ka->p.ws;
#endif
    return p; }
#ifndef MK_REP
#define MK_REP 0ull
#endif
#define REP(k) (((MK_REP) >> (k)) & 1ull)
#define IN(k) (lo <= (k) && (k) < hi)
#define SEAM(k) do { if (IN(k) && IN((k) + 1)) xcd_barrier(bar); } while (0)
template <int L> __device__ __forceinline__ void run_layer_phases(KArgs ka, unsigned char* lds, const XcdBarrier& bar, int lo, int hi) {
    constexpr int B = 1 + 9 * L;
    if (IN(B + 0)) { const P p = load_p(ka); ph_norm1<L>(p, lds); } SEAM(B + 0);
    if (IN(B + 1)) { const P p = load_p(ka); ph_qkv<L>(p, lds); if (REP(B + 1)) { xcd_barrier(bar); ph_qkv<L>(p, lds); } } SEAM(B + 1);
    if (L == 0 || L == 2) { if (IN(B + 2)) { const P p = load_p(ka); ph_rope<L>(p, lds); } SEAM(B + 2); }
    if (IN(B + 3)) { const P p = load_p(ka); ph_attn<L>(p, lds); if (REP(B + 3)) { xcd_barrier(bar); ph_attn<L>(p, lds); } } SEAM(B + 3);
    if (IN(B + 4)) { const P p = load_p(ka); ph_wo<L>(p, lds); } SEAM(B + 4);
    if (IN(B + 5)) { const P p = load_p(ka); ph_norm2<L>(p, lds); } SEAM(B + 5);
    if (IN(B + 7)) { const P p = load_p(ka); ph_moe1<L>(p, lds); if (REP(B + 7)) { xcd_barrier(bar); ph_moe1<L>(p, lds); } } SEAM(B + 7);
    if (IN(B + 8)) { const P p = load_p(ka); ph_moe2<L>(p, lds, IN(B + 7)); if (REP(B + 8)) { xcd_barrier(bar); ph_moe2<L>(p, lds, IN(B + 7)); } } SEAM(B + 8);
}
__global__ void __launch_bounds__(512, 2) mk_fwd(Args a_unused) {
    extern __shared__ __attribute__((aligned(16))) unsigned char lds[];
    KArgs ka = (KArgs)__builtin_amdgcn_kernarg_segment_ptr();
    for (int u = threadIdx.x; u < (LDS_BYTES - MISC_OFF) / 4; u += 512) ((unsigned*)(lds + MISC_OFF))[u] = 0u;
    __syncthreads();
    const XcdBarrier bar = xcd_barrier_post((unsigned*)(ka->p.ws + WS_CTL) + CW_BAR + ka->li * XCD_BAR_WORDS, (volatile LAS unsigned*)(lds + MISC_OFF));
    const int lo = ka->ph_lo, hi = ka->ph_hi;
    if (IN(0)) { const P p = load_p(ka); ph_modvec(p, lds); ph_weights(p, lds); if (REP(0)) { xcd_barrier(bar); ph_weights(p, lds); } } SEAM(0);
    run_layer_phases<0>(ka, lds, bar, lo, hi);
    run_layer_phases<1>(ka, lds, bar, lo, hi);
    run_layer_phases<2>(ka, lds, bar, lo, hi);
    run_layer_phases<3>(ka, lds, bar, lo, hi);
    if (IN(37)) { const P p = load_p(ka); ph_norm1<4>(p, lds); }
}
#undef IN
#undef SEAM
#undef REP

#ifndef MK_NAIVE_ATTN
#define MK_NAIVE_ATTN 0
#endif
#ifndef MK_NAIVE_GEMM
#define MK_NAIVE_GEMM 0
#endif
#ifndef MK_SPLIT_ALL
#define MK_SPLIT_ALL 0
#endif
template <int L> static void naive_phase(const P& p, int sub, hipStream_t stream) {
    constexpr int NQKV = (L == 0 || L == 3) ? 3072 : 1536;
    constexpr int IQ = L == 0 ? I_AQKV : L == 1 ? I_BQKV : L == 2 ? I_CQKV : I_DQKV, IO = L == 0 ? I_AWO : L == 1 ? I_BWO : L == 2 ? I_CWO : I_DWO;
    unsigned char* ws = p.ws; const float* modv = (const float*)(ws + WS_MODV);
    const int* gcnt = (const int*)(ws + WS_CTL) + CW_CNT + L * 32;
    if (sub == 1) { NG g{}; g.A = (const bf16*)(ws + WS_H); g.lda = D; g.W = p.in[IQ]; g.N = NQKV; g.K = D; g.mtiles = T / 64; g.C = (bf16*)(ws + WS_QKV); g.ldc = NQKV;
        hipLaunchKernelGGL(k_ngemm<0>, dim3(2048), dim3(256), 0, stream, g); }
    if (sub == 3) hipLaunchKernelGGL(k_nattn<L>, dim3(160), dim3(512), 0, stream, p);
    if (sub == 4) { NG g{}; g.A = (const bf16*)(ws + WS_O); g.lda = D; g.W = p.in[IO]; g.N = D; g.K = D; g.mtiles = (L == 3 ? SEQ : T) / 64; g.row_off = L == 3 ? CTX : 0; g.X = (float*)(ws + WS_X);
        g.gate_lat = modv + (size_t)(L * 2) * 6144 + 2048; g.gate_ctx = modv + (size_t)(L * 2 + 1) * 6144 + 2048;
        hipLaunchKernelGGL(k_ngemm<1>, dim3(2048), dim3(256), 0, stream, g); }
    if (sub == 7) { NG g{}; g.A = (const bf16*)(ws + WS_XB); g.lda = D; g.W = p.in[I_WGATE] + (size_t)L * 32 * 1024 * 512; g.W2 = p.in[I_WUP] + (size_t)L * 32 * 1024 * 512; g.N = DEXP; g.K = D; g.wstride = (size_t)1024 * 512;
        g.gcnt = gcnt; g.C = (bf16*)(ws + WS_HID); g.ldc = DEXP;
        hipLaunchKernelGGL(k_ngemm<2>, dim3(2048), dim3(256), 0, stream, g); }
    if (sub == 8) { NG g{}; g.A = (const bf16*)(ws + WS_HID); g.lda = DEXP; g.W = p.in[I_WDOWN] + (size_t)L * 32 * 512 * 1024; g.N = D; g.K = DEXP; g.wstride = (size_t)512 * 1024;
        g.gcnt = gcnt; g.C = (bf16*)(ws + WS_YB); g.ldc = D;
        hipLaunchKernelGGL(k_ngemm<0>, dim3(2048), dim3(256), 0, stream, g); }
}
static bool phase_is_naive(int k) {
    if (k < 1 || k > 36) return false;
    const int L = (k - 1) / 9, sub = (k - 1) % 9;
    if (sub == 3) return (MK_NAIVE_ATTN >> L) & 1;
    if (sub == 1) return MK_NAIVE_GEMM & 1;
    if (sub == 4) return (MK_NAIVE_GEMM >> 1) & 1;
    if (sub == 7) return (MK_NAIVE_GEMM >> 2) & 1;
    if (sub == 8) return (MK_NAIVE_GEMM >> 3) & 1;
    return false;
}
extern "C" void kernel_launch(void* const* d_in, const int* in_sizes, int n_in, void* d_out, int out_size, void* d_ws, size_t ws_size, hipStream_t stream) {
    static int grid = 0;
    if (grid == 0) {
        if (n_in != 29 || out_size != SEQ * D || ws_size < WS_END) { fprintf(stderr, "kernel_launch: unexpected shapes n_in %d out %d ws %zu\n", n_in, out_size, ws_size); grid = -1; return; }
        int dev = 0, cus = 0, per_cu = 0;
        if (hipGetDevice(&dev) != hipSuccess || hipDeviceGetAttribute(&cus, hipDeviceAttributeMultiprocessorCount, dev) != hipSuccess) { grid = -1; return; }
        if (hipFuncSetAttribute((const void*)mk_fwd, hipFuncAttributeMaxDynamicSharedMemorySize, LDS_BYTES) != hipSuccess) { fprintf(stderr, "kernel_launch: hipFuncSetAttribute failed\n"); grid = -1; return; }
        if (hipOccupancyMaxActiveBlocksPerMultiprocessor(&per_cu, (const void*)mk_fwd, 512, LDS_BYTES) != hipSuccess || per_cu < 1)
            fprintf(stderr, "kernel_launch: note: occupancy query reports %d blocks per CU\n", per_cu);
        (void)hipGetLastError();
        grid = cus;
    }
    if (grid < 0) return;
    Args a{};
    for (int i = 0; i < 29; ++i) a.p.in[i] = (const float*)d_in[i];
    a.p.out = (float*)d_out; a.p.ws = (unsigned char*)d_ws;
    (void)hipMemsetAsync((char*)d_ws + WS_CTL, 0, CTL_ZERO_BYTES, stream);
    int cur = 0, li = 0;
    auto flush = [&](int lo, int hi) { if (lo >= hi) return; a.ph_lo = lo; a.ph_hi = hi; a.li = li++; hipLaunchKernelGGL(mk_fwd, dim3(grid), dim3(512), LDS_BYTES, stream, a); };
    for (int k = 0; k < NPHASE; ++k) {
        if (phase_is_naive(k)) { flush(cur, k); cur = k + 1; const int L = (k - 1) / 9, sub = (k - 1) % 9;
            if (L == 0) naive_phase<0>(a.p, sub, stream); else if (L == 1) naive_phase<1>(a.p, sub, stream); else if (L == 2) naive_phase<2>(a.p, sub, stream); else naive_phase<3>(a.p, sub, stream); }
        else if (MK_SPLIT_ALL) { flush(cur, k + 1); cur = k + 1; }
    }
    flush(cur, NPHASE);
}
```
